# Optimizing an MI355X kernel written in HIP

```python
import math
import jax, jax.numpy as jnp
from jax import lax
import numpy as np

D_MODEL = 2048
BATCH = 32
SEQ = 256
DEPTH = 1
DEC_BATCH = 2
DEC_SEQ = 2048
PAST_LEN = 256

GRID_W = 64
D_A = 1024
HEAD = 64
H_A = D_A // HEAD
LORA_W = 64
LORA_A = 64
LORA_G = 160
D_B = 1024
CHUNK = 128
G_B = 8
C_B = D_B // G_B
D_FF = 5504
N_SHIFT = 3 * D_A + LORA_W + LORA_A + LORA_G
N_IN = N_SHIFT + 2 * D_B + 2 * D_MODEL
RW_SPLITS = (D_A, 2 * D_A, 3 * D_A, 3 * D_A + LORA_W, 3 * D_A + LORA_W + LORA_A)
ALPHA = (2.0 * DEPTH) ** 0.25
BETA = (8.0 * DEPTH) ** -0.25
LN_EPS = 1e-5
GN_EPS = 64e-5
NRM_EPS = 1e-12

kernel_name = 'hybrid_rwkv7_gmlp_diffusion_step'


def _layernorm(x, g, b, eps=LN_EPS):
    xf = x.astype(jnp.float32)
    mu = jnp.mean(xf, -1, keepdims=True)
    var = jnp.mean(jnp.square(xf - mu), -1, keepdims=True)
    return ((xf - mu) * lax.rsqrt(var + eps)).astype(x.dtype) * g + b


def _swiglu(h, w_in, w_out):
    a, b = jnp.split(h @ w_in, 2, axis=-1)
    return (jax.nn.silu(a) * b) @ w_out


def _neighbour_mean(s, on_grid):
    if on_grid:
        B, T, C = s.shape
        rows = T // GRID_W
        p = jnp.pad(s.reshape(B, rows, GRID_W, C), ((0, 0), (1, 1), (1, 1), (0, 0)))
        nb = (p[:, :-2, 1:-1] + p[:, 2:, 1:-1] + p[:, 1:-1, :-2] + p[:, 1:-1, 2:]) * 0.25
        return nb.reshape(B, T, C)
    p = jnp.pad(s, ((0, 0), (1, 1), (0, 0)))
    return (p[:, :-2] + p[:, 2:]) * 0.5


def _rwkv_scan(S0, r, w, k, v, kk, b, reverse):
    def step(S, inp):
        r_t, w_t, k_t, v_t, kk_t, b_t = inp
        Skk = jnp.einsum('bhvk,bhk->bhv', S, kk_t)
        S = S * w_t[:, :, None, :] - Skk[..., None] * b_t[:, :, None, :] + v_t[..., None] * k_t[:, :, None, :]
        return S, jnp.einsum('bhvk,bhk->bhv', S, r_t)
    xs = tuple(jnp.swapaxes(a, 0, 1) for a in (r, w, k, v, kk, b))
    S_T, ys = lax.scan(step, S0, xs, reverse=reverse)
    return S_T, jnp.swapaxes(ys, 0, 1)


def _rwkv_branch(z, S0f, S0b, w0, w2, a0, a2, g2, k_k, k_a, r_k, gn_g, gn_b):
    z = z.astype(jnp.float32)
    B, T, _ = z.shape
    hd = lambda t: t.reshape(B, T, H_A, HEAD)
    r, k, v, xw, xa, xg = jnp.split(z, RW_SPLITS, axis=-1)
    g = jax.nn.sigmoid(xg) @ g2
    kk = hd(k * k_k)
    kk = kk / jnp.maximum(jnp.sqrt(jnp.sum(kk * kk, -1, keepdims=True)), NRM_EPS)
    r4, v4 = hd(r), hd(v)
    inits = (S0f.astype(jnp.float32), S0b.astype(jnp.float32))
    y = jnp.zeros_like(r4)
    bonus = jnp.zeros_like(r4)
    finals = []
    for d in range(2):
        wlog = -jax.nn.softplus(-(w0[d] + jnp.tanh(xw) @ w2[d])) - 0.5
        decay = jnp.exp(-jnp.exp(wlog))
        a = jax.nn.sigmoid(a0[d] + xa @ a2[d])
        kd = hd(k * (1.0 + (a - 1.0) * k_a))
        S_T, yd = _rwkv_scan(inits[d], r4, hd(decay), kd, v4, kk, kk * hd(a), reverse=(d == 1))
        y = y + yd
        bonus = bonus + jnp.sum(r4 * kd * r_k, -1, keepdims=True) * v4
        finals.append(S_T)
    mu = jnp.mean(y, -1, keepdims=True)
    var = jnp.mean(jnp.square(y - mu), -1, keepdims=True)
    yn = ((y - mu) * lax.rsqrt(var + GN_EPS)).reshape(B, T, D_A) * gn_g + gn_b
    out = (yn + bonus.reshape(B, T, D_A)) * g
    return out, finals[0], finals[1]


def _spatial_gating(uv, ln_g, ln_b, w_s, b_s):
    u, v = jnp.split(uv, 2, axis=-1)
    v = _layernorm(v, ln_g, ln_b)
    B, T, _ = v.shape
    vc = v.reshape(B, T // CHUNK, CHUNK, G_B, C_B)
    s = jnp.einsum('gpq,bnqgc->bnpgc', w_s, vc) + jnp.transpose(b_s)[None, None, :, :, None]
    return u * s.reshape(B, T, D_B)


def _layer(x, cond, on_grid, S0f, S0b, p):
    mod = (jax.nn.silu(cond) @ p['w_ada'] + p['b_ada']).reshape(cond.shape[0], 1, 9, D_MODEL)
    shift = lambda i: mod[:, :, 3 * i]
    scale = lambda i: mod[:, :, 3 * i + 1]
    gate = lambda i: mod[:, :, 3 * i + 2]
    modulate = lambda t, i: t * (1.0 + scale(i)) + shift(i)
    f1 = _swiglu(modulate(x, 0), p['ffn_w_in'][0], p['ffn_w_out'][0])
    x = _layernorm(ALPHA * x + 0.5 * gate(0) * f1, p['ln_g'][0], p['ln_b'][0])
    h = modulate(x, 1)
    proj = h @ p['w_in']
    zs = proj[..., :N_SHIFT]
    zs = zs + p['shift_mu'] * (_neighbour_mean(zs, on_grid) - zs)
    yA, Sf, Sb = _rwkv_branch(zs, S0f, S0b, p['rw_w0'], p['rw_w2'], p['rw_a0'], p['rw_a2'], p['rw_g2'],
                              p['rw_k_k'], p['rw_k_a'], p['rw_r_k'], p['rw_gn_g'], p['rw_gn_b'])
    uv = jax.nn.gelu(proj[..., N_SHIFT:N_SHIFT + 2 * D_B], approximate=False)
    yB = _spatial_gating(uv, p['sg_ln_g'], p['sg_ln_b'], p['sg_w'], p['sg_b'])
    gts = jax.nn.sigmoid(proj[..., N_SHIFT + 2 * D_B:])
    merged = gts[..., :D_MODEL] * (yA.astype(x.dtype) @ p['w_pa']) + gts[..., D_MODEL:] * (yB @ p['w_pb'])
    x = _layernorm(ALPHA * x + gate(1) * (merged @ p['w_o']), p['ln_g'][1], p['ln_b'][1])
    f2 = _swiglu(modulate(x, 2), p['ffn_w_in'][1], p['ffn_w_out'][1])
    x = _layernorm(ALPHA * x + 0.5 * gate(2) * f2, p['ln_g'][2], p['ln_b'][2])
    return x, Sf, Sb


def setup_inputs(seed: int = 0) -> dict:
    key = jax.random.key(seed)
    ks = jax.random.split(key, 40)
    nrm = lambda k, shape, s: jax.random.normal(k, shape, jnp.float32) * s
    L = DEPTH
    return {
        'x_prompt': nrm(ks[0], (BATCH, SEQ, D_MODEL), 1.0),
        'x_sample': nrm(ks[1], (DEC_BATCH, DEC_SEQ, D_MODEL), 1.0),
        'c': nrm(ks[2], (DEC_BATCH, D_MODEL), 1.0),
        'state_rwkv_fwd': nrm(ks[3], (DEC_BATCH, L, H_A, HEAD, HEAD), 0.1),
        'state_rwkv_bwd': nrm(ks[4], (DEC_BATCH, L, H_A, HEAD, HEAD), 0.1),
        'c_ctx': nrm(ks[5], (D_MODEL,), 1.0),
        'w_ada': nrm(ks[6], (L, D_MODEL, 9 * D_MODEL), 0.5 * D_MODEL ** -0.5),
        'b_ada': nrm(ks[7], (L, 9 * D_MODEL), 0.01),
        'ln_g': 1.0 + nrm(ks[8], (L, 3, D_MODEL), 0.01),
        'ln_b': nrm(ks[9], (L, 3, D_MODEL), 0.01),
        'ffn_w_in': nrm(ks[10], (L, 2, D_MODEL, 2 * D_FF), D_MODEL ** -0.5),
        'ffn_w_out': nrm(ks[11], (L, 2, D_FF, D_MODEL), BETA * D_FF ** -0.5),
        'w_in': nrm(ks[12], (L, D_MODEL, N_IN), D_MODEL ** -0.5),
        'shift_mu': jax.random.uniform(ks[13], (L, N_SHIFT), jnp.float32),
        'rw_w0': jax.random.uniform(ks[14], (L, 2, D_A), jnp.float32, minval=-3.0, maxval=0.0),
        'rw_w2': nrm(ks[15], (L, 2, LORA_W, D_A), 0.1 * LORA_W ** -0.5),
        'rw_a0': nrm(ks[16], (L, 2, D_A), 0.1),
        'rw_a2': nrm(ks[17], (L, 2, LORA_A, D_A), 0.1 * LORA_A ** -0.5),
        'rw_g2': nrm(ks[18], (L, LORA_G, D_A), LORA_G ** -0.5),
        'rw_k_k': 0.85 + nrm(ks[19], (L, D_A), 0.02),
        'rw_k_a': 1.0 + nrm(ks[20], (L, D_A), 0.02),
        'rw_r_k': nrm(ks[21], (L, H_A, HEAD), 0.1),
        'rw_gn_g': 1.0 + nrm(ks[22], (L, D_A), 0.01),
        'rw_gn_b': nrm(ks[23], (L, D_A), 0.01),
        'sg_ln_g': 1.0 + nrm(ks[24], (L, D_B), 0.01),
        'sg_ln_b': nrm(ks[25], (L, D_B), 0.01),
        'sg_w': nrm(ks[26], (L, G_B, CHUNK, CHUNK), 0.5 * CHUNK ** -0.5),
        'sg_b': 1.0 + nrm(ks[27], (L, G_B, CHUNK), 0.01),
        'w_pa': nrm(ks[28], (L, D_A, D_MODEL), D_A ** -0.5),
        'w_pb': nrm(ks[29], (L, D_B, D_MODEL), D_B ** -0.5),
        'w_o': nrm(ks[30], (L, D_MODEL, D_MODEL), BETA * D_MODEL ** -0.5),
    }


def reference(x_prompt, x_sample, c, state_rwkv_fwd, state_rwkv_bwd, c_ctx, w_ada, b_ada, ln_g, ln_b,
              ffn_w_in, ffn_w_out, w_in, shift_mu, rw_w0, rw_w2, rw_a0, rw_a2, rw_g2, rw_k_k, rw_k_a,
              rw_r_k, rw_gn_g, rw_gn_b, sg_ln_g, sg_ln_b, sg_w, sg_b, w_pa, w_pb, w_o):
    xp, xs = x_prompt, x_sample
    zero_state = jnp.zeros((x_prompt.shape[0], H_A, HEAD, HEAD), jnp.float32)
    cond_ctx = c_ctx[None, :]
    new_f, new_b = [], []
    for l in range(DEPTH):
        p = {'w_ada': w_ada[l], 'b_ada': b_ada[l], 'ln_g': ln_g[l], 'ln_b': ln_b[l],
             'ffn_w_in': ffn_w_in[l], 'ffn_w_out': ffn_w_out[l], 'w_in': w_in[l], 'shift_mu': shift_mu[l],
             'rw_w0': rw_w0[l], 'rw_w2': rw_w2[l], 'rw_a0': rw_a0[l], 'rw_a2': rw_a2[l], 'rw_g2': rw_g2[l],
             'rw_k_k': rw_k_k[l], 'rw_k_a': rw_k_a[l], 'rw_r_k': rw_r_k[l], 'rw_gn_g': rw_gn_g[l],
             'rw_gn_b': rw_gn_b[l], 'sg_ln_g': sg_ln_g[l], 'sg_ln_b': sg_ln_b[l], 'sg_w': sg_w[l],
             'sg_b': sg_b[l], 'w_pa': w_pa[l], 'w_pb': w_pb[l], 'w_o': w_o[l]}
        xp, sf, sb = _layer(xp, cond_ctx, False, zero_state, zero_state, p)
        new_f.append(sf)
        new_b.append(sb)
        xs, _, _ = _layer(xs, c, True, state_rwkv_fwd[:, l], state_rwkv_bwd[:, l], p)
    new_state_fwd = jnp.stack(new_f, axis=1).astype(x_prompt.dtype)
    new_state_bwd = jnp.stack(new_b, axis=1).astype(x_prompt.dtype)
    return (xp, xs, new_state_fwd, new_state_bwd)
```

```cpp
#include <hip/hip_runtime.h>
#include <hip/hip_cooperative_groups.h>
#include <cstdio>
#include <cstdint>
namespace cg = cooperative_groups;

#ifndef COOP
#define COOP 1
#endif

#define LAS __attribute__((address_space(3)))
typedef unsigned short bf16_t;
typedef short bf16x8 __attribute__((ext_vector_type(8)));
typedef float f32x4 __attribute__((ext_vector_type(4)));
typedef float f32x2 __attribute__((ext_vector_type(2)));
typedef unsigned u32x4 __attribute__((ext_vector_type(4)));
typedef unsigned u32x2 __attribute__((ext_vector_type(2)));

constexpr int M_TOK = 12288, M_CTX = 8192, DM = 2048, DFF = 5504, DA = 1024, NZS = 3360, KL = 384, NMOD = 18432;
constexpr float ALPHA = 1.189207115f, LN_EPS = 1e-5f, GN_EPS = 64e-5f;
constexpr int NPH = 17;
constexpr int LDS_BYTES = 147456;

constexpr size_t O_MOD = 0, O_XRES = 262144, O_W = O_XRES + 100663296ull, O_T = O_W + 67633152ull;
constexpr size_t WF_IN = O_W, WF_OUT = O_W + 45088768ull;
constexpr size_t WM_IN = O_W, WM_PA = O_W + 39845888ull, WM_PB = WM_PA + 4194304ull, WM_O = WM_PB + 4194304ull, WM_L = WM_O + 8388608ull;
constexpr size_t O_ABUF = O_T, O_HID = O_T + 50331648ull, O_PRE = O_T + 185597952ull;
constexpr size_t O_ZS = O_T + 50331648ull, O_DEC = O_ZS, O_Y = O_ZS + 100663296ull, O_GTS = O_ZS;
constexpr size_t O_UV = O_T + 215482368ull;
constexpr size_t O_R = O_T + 265814016ull, O_K = O_R + 50331648ull, O_V = O_K + 50331648ull, O_KK = O_V + 50331648ull, O_M1 = O_R;
constexpr size_t O_ABF = O_T + 467140608ull, O_G = O_T + 517472256ull, O_LB = O_T + 542638080ull;
constexpr size_t O_PREB = O_PRE + 100663296ull + 4194304ull;
constexpr size_t WF2_IN = O_KK, WF2_OUT = O_KK + 45088768ull;
constexpr size_t WS_NEED = O_LB + 9437184ull;
constexpr size_t OUT_SF = 25165824ull, OUT_SB = OUT_SF + 2097152ull;

struct Params { const float* in[31]; float* out; unsigned char* ws; };

__device__ __forceinline__ f32x4 ld4(const float* p) { return *(const f32x4*)p; }
__device__ __forceinline__ void st4(float* p, f32x4 v) { *(f32x4*)p = v; }
typedef __bf16 bf16x2_t __attribute__((ext_vector_type(2)));
__device__ __forceinline__ unsigned cvt_pk_bf16(float lo, float hi) { bf16x2_t v = {(__bf16)lo, (__bf16)hi}; return __builtin_bit_cast(unsigned, v); }
__device__ __forceinline__ float bflo(unsigned u) { return __uint_as_float(u << 16); }
__device__ __forceinline__ float bfhi(unsigned u) { return __uint_as_float(u & 0xffff0000u); }
__device__ __forceinline__ f32x4 ldbf4(const bf16_t* p) { const u32x2 w = *(const u32x2*)p; return (f32x4){bflo(w.x), bfhi(w.x), bflo(w.y), bfhi(w.y)}; }
__device__ __forceinline__ void stbf8(bf16_t* p, f32x4 v0, f32x4 v1) { u32x4 w; w.x = cvt_pk_bf16(v0[0], v0[1]); w.y = cvt_pk_bf16(v0[2], v0[3]); w.z = cvt_pk_bf16(v1[0], v1[1]); w.w = cvt_pk_bf16(v1[2], v1[3]); *(u32x4*)p = w; }
__device__ __forceinline__ void unpack8(const u32x4 w, f32x4& lo, f32x4& hi) { lo = (f32x4){bflo(w.x), bfhi(w.x), bflo(w.y), bfhi(w.y)}; hi = (f32x4){bflo(w.z), bfhi(w.z), bflo(w.w), bfhi(w.w)}; }
__device__ __forceinline__ void shift16(const bf16_t* z, const bf16_t* z0, const bf16_t* z1, const bf16_t* z2, const bf16_t* z3, const float* mu, int cb, bool lat,
                                        float f0, float f1, float f2, float f3, float wgt, f32x4 (&out)[4]) {
    const u32x4 zA = *(const u32x4*)(z + cb), zB = *(const u32x4*)(z + cb + 8);
    const u32x4 aA = *(const u32x4*)(z0 + cb), aB = *(const u32x4*)(z0 + cb + 8);
    const u32x4 bA = *(const u32x4*)(z1 + cb), bB = *(const u32x4*)(z1 + cb + 8);
    u32x4 cA = zA, cB = zB, dA = zA, dB = zB;
    if (lat) { cA = *(const u32x4*)(z2 + cb); cB = *(const u32x4*)(z2 + cb + 8); dA = *(const u32x4*)(z3 + cb); dB = *(const u32x4*)(z3 + cb + 8); }
    f32x4 zz[4], n0[4], n1[4];
    unpack8(zA, zz[0], zz[1]); unpack8(zB, zz[2], zz[3]);
    unpack8(aA, n0[0], n0[1]); unpack8(aB, n0[2], n0[3]);
    unpack8(bA, n1[0], n1[1]); unpack8(bB, n1[2], n1[3]);
#pragma unroll
    for (int q = 0; q < 4; ++q) n0[q] = n0[q] * f0 + n1[q] * f1;
    if (lat) {
        f32x4 n2[4], n3[4];
        unpack8(cA, n2[0], n2[1]); unpack8(cB, n2[2], n2[3]);
        unpack8(dA, n3[0], n3[1]); unpack8(dB, n3[2], n3[3]);
#pragma unroll
        for (int q = 0; q < 4; ++q) n0[q] += n2[q] * f2 + n3[q] * f3;
    }
#pragma unroll
    for (int q = 0; q < 4; ++q) out[q] = zz[q] + ld4(mu + cb + q * 4) * (n0[q] * wgt - zz[q]);
}
__device__ __forceinline__ float sigmoidf_(float x) { return __builtin_amdgcn_rcpf(1.0f + __expf(-x)); }
__device__ __forceinline__ float wsum(float x) {
#pragma unroll
    for (int o = 32; o > 0; o >>= 1) x += __shfl_xor(x, o);
    return x;
}
__device__ __forceinline__ f32x2 gelu_pk(f32x2 v) {
    const f32x2 av = __builtin_elementwise_abs(v), d = av * 0.2316418882f + 1.0f;
    f32x2 t; t.x = __builtin_amdgcn_rcpf(d.x); t.y = __builtin_amdgcn_rcpf(d.y);
    f32x2 q = t * 0.5307027145f + (-0.7265760135f); q = q * t + 0.7107068705f; q = q * t + (-0.142248368f); q = q * t + 0.127414796f; q = q * t;
    const f32x2 s = (v * v) * (-0.72134752044f);
    f32x2 e; e.x = __builtin_amdgcn_exp2f(s.x); e.y = __builtin_amdgcn_exp2f(s.y);
    const f32x2 m = v * (q * e), r = v - m;
    f32x2 o; o.x = v.x < 0.f ? m.x : r.x; o.y = v.y < 0.f ? m.y : r.y; return o;
}
__device__ __forceinline__ int cond_of_row(int row) { return row < M_CTX ? 0 : 1 + ((row - M_CTX) >> 11); }

namespace pg8 {
constexpr int BM = 256, BK = 64, HALF = 128, HTB = HALF * BK * 2, STAGE_BYTES = 8 * HTB, NXCD = 8, WGM = 8;
__device__ __forceinline__ int lds_byte(int r, int c) { const int st = (r >> 4) * 2 + (c >> 5), rr = r & 15, cc = c & 31, ob = rr * 64 + cc * 2; return st * 1024 + (ob ^ (((ob >> 9) & 1) << 5)); }
__device__ __forceinline__ void stage_rc(int b, int& R, int& C) { const int st = b / 1024, sb = b % 1024, swz = sb ^ (((sb >> 9) & 1) << 5); R = (st >> 1) * 16 + swz / 64; C = (st & 1) * 32 + (swz % 64) / 2; }
__device__ __forceinline__ int perm32(int rho) { const int n = rho >> 4, i = rho & 15; return 8 * (i >> 2) + 4 * n + (i & 3); }
struct Unit { int pm, pn; };
struct Gemm { const bf16_t* A; const bf16_t* Bt; int M, N, K, lda, ldb; };
struct StaticOrder {
    int nM, nN, nwg, G, c;
    __device__ void init(int M, int N, int G_, int c_) { nM = M / BM; nN = N / BM; nwg = nM * nN; G = G_; c = c_; }
    __device__ bool next(int i, Unit& u) const {
        const long L = (long)i * G + c; if (L >= nwg) return false;
        int wgid = (int)L; { const int q = nwg / NXCD, r = nwg % NXCD, xcd = wgid % NXCD, off = wgid / NXCD; wgid = (xcd < r ? xcd * (q + 1) : r * (q + 1) + (xcd - r) * q) + off; }
        const int nig = WGM * nN, gid = wgid / nig, fm = gid * WGM, gsz = (nM - fm) < WGM ? (nM - fm) : WGM;
        u.pm = fm + ((wgid % nig) % gsz); u.pn = (wgid % nig) / gsz; return true;
    }
};
template <class Epi>
__device__ __forceinline__ void gemm_phase(LAS unsigned char* lds, const Gemm g, const StaticOrder& S, const Epi& E) {
    const int tid = threadIdx.x, wid = __builtin_amdgcn_readfirstlane(tid >> 6), lane = tid & 63, wr = wid >> 2, wc = wid & 3, fr = lane & 15, fq = lane >> 4;
    const int K = g.K, nt = K / BK, lda = g.lda, ldb = g.ldb ? g.ldb : g.K;
    unsigned voffA[2], voffB[2];
#pragma unroll
    for (int i = 0; i < 2; ++i) { int R, C; stage_rc(tid * 16 + i * 8192, R, C); const int Rb = (R & ~31) + perm32(R & 31);
        voffA[i] = (unsigned)(R * lda + C) * 2u; voffB[i] = (unsigned)(Rb * ldb + C) * 2u; }
    const size_t kstep = (size_t)(BK * 2);
    const size_t hstepA = (size_t)HALF * lda * 2, hstepB = (size_t)HALF * ldb * 2;
    const size_t tstepA = 2 * hstepA, tstepB = 2 * hstepB;
    const unsigned ldsw = (unsigned)wid * 1024u;
    const int aoff = lds_byte(wr * 64 + fr, fq * 8), boff = lds_byte(wc * 32 + fr, fq * 8);
#define PG8_SA(b, h) (((b) * 2 + (h)) * HTB)
#define PG8_SB(b, h) ((4 + (b) * 2 + (h)) * HTB)
#define PG8_STAGE(bufoff, gbase, voff) do { _Pragma("unroll") for (int _i = 0; _i < 2; ++_i) \
        __builtin_amdgcn_global_load_lds((const unsigned*)((const char*)(gbase) + (voff)[_i]), (LAS unsigned*)(lds + (bufoff) + ldsw + _i * 8192), 16, 0, 0); } while (0)
#define PG8_LDA(dst, b, h) do { _Pragma("unroll") for (int m = 0; m < 4; ++m) _Pragma("unroll") for (int k = 0; k < 2; ++k) dst[m][k] = *(const LAS bf16x8*)(lds + PG8_SA(b, h) + aoff + m * 2048 + k * 1024); } while (0)
#define PG8_LDB(dst, b, h) do { _Pragma("unroll") for (int n = 0; n < 2; ++n) _Pragma("unroll") for (int k = 0; k < 2; ++k) dst[n][k] = *(const LAS bf16x8*)(lds + PG8_SB(b, h) + boff + n * 2048 + k * 1024); } while (0)
#define PG8_MMA(ai, bj, At, Bt) do { __builtin_amdgcn_s_setprio(1); _Pragma("unroll") for (int m = 0; m < 4; ++m) _Pragma("unroll") for (int n = 0; n < 2; ++n) _Pragma("unroll") for (int k = 0; k < 2; ++k) \
        acc[ai][bj][m][n] = __builtin_amdgcn_mfma_f32_16x16x32_bf16(Bt[n][k], At[m][k], acc[ai][bj][m][n], 0, 0, 0); __builtin_amdgcn_s_setprio(0); } while (0)
#define PG8_WAIT_V(n) asm volatile("s_waitcnt vmcnt(" #n ")" ::: "memory")
#define PG8_WAIT_L(n) asm volatile("s_waitcnt lgkmcnt(" #n ")" ::: "memory")
#define PG8_BAR __builtin_amdgcn_s_barrier()
#define PG8_SCHED __builtin_amdgcn_sched_barrier(0)
    Unit cur, nxt; int ui = 0;
    if (!S.next(0, cur)) return;
    f32x4 acc[2][2][4][2];
#pragma unroll
    for (int a = 0; a < 2; ++a)
#pragma unroll
        for (int b = 0; b < 2; ++b)
#pragma unroll
            for (int m = 0; m < 4; ++m)
#pragma unroll
                for (int n = 0; n < 2; ++n) acc[a][b][m][n] = (f32x4){0.f, 0.f, 0.f, 0.f};
    bf16x8 At[4][2], B0[2][2], B1[2][2];
    const char* cA = (const char*)g.A + (size_t)cur.pm * tstepA; const char* cB = (const char*)g.Bt + (size_t)cur.pn * tstepB;
    PG8_STAGE(PG8_SB(0, 0), cB, voffB); PG8_STAGE(PG8_SA(0, 0), cA, voffA); PG8_STAGE(PG8_SB(0, 1), cB + hstepB, voffB); PG8_STAGE(PG8_SA(0, 1), cA + hstepA, voffA);
    if (wr == 1) PG8_BAR;
    PG8_WAIT_V(4); PG8_BAR;
    PG8_STAGE(PG8_SB(1, 0), cB + kstep, voffB); PG8_STAGE(PG8_SA(1, 0), cA + kstep, voffA); PG8_STAGE(PG8_SB(1, 1), cB + hstepB + kstep, voffB);
    PG8_WAIT_V(6); PG8_BAR;
    for (;;) {
        const bool has_next = S.next(ui + 1, nxt);
        const char* nA = has_next ? (const char*)g.A + (size_t)nxt.pm * tstepA : cA; const char* nB = has_next ? (const char*)g.Bt + (size_t)nxt.pn * tstepB : cB;
        for (int t = 0; t < nt; t += 2) {
            const bool last = (t == nt - 2);
            const char* a1 = cA + (size_t)(t + 1) * kstep;
            const char* a2 = last ? nA : cA + (size_t)(t + 2) * kstep; const char* b2 = last ? nB : cB + (size_t)(t + 2) * kstep;
            const char* a3 = a2 + kstep; const char* b3 = b2 + kstep;
            PG8_LDB(B0, 0, 0); PG8_SCHED; PG8_LDA(At, 0, 0); PG8_STAGE(PG8_SA(1, 1), a1 + hstepA, voffA);
            PG8_WAIT_L(8); PG8_BAR; PG8_WAIT_L(0); PG8_MMA(0, 0, At, B0); PG8_BAR; PG8_SCHED;
            PG8_LDB(B1, 0, 1); PG8_STAGE(PG8_SB(0, 0), b2, voffB);
            PG8_BAR; PG8_WAIT_L(0); PG8_MMA(0, 1, At, B1); PG8_BAR;
            PG8_LDA(At, 0, 1); PG8_STAGE(PG8_SA(0, 0), a2, voffA);
            PG8_BAR; PG8_WAIT_L(0); PG8_MMA(1, 0, At, B0); PG8_BAR; PG8_SCHED;
            PG8_STAGE(PG8_SB(0, 1), b2 + hstepB, voffB);
            PG8_WAIT_V(6); PG8_BAR; PG8_MMA(1, 1, At, B1); PG8_BAR;
            PG8_LDB(B0, 1, 0); PG8_SCHED; PG8_LDA(At, 1, 0); PG8_STAGE(PG8_SA(0, 1), a2 + hstepA, voffA);
            PG8_WAIT_L(8); PG8_BAR; PG8_WAIT_L(0); PG8_MMA(0, 0, At, B0); PG8_BAR; PG8_SCHED;
            PG8_LDB(B1, 1, 1); PG8_STAGE(PG8_SB(1, 0), b3, voffB);
            PG8_BAR; PG8_WAIT_L(0); PG8_MMA(0, 1, At, B1); PG8_BAR;
            PG8_LDA(At, 1, 1); PG8_STAGE(PG8_SA(1, 0), a3, voffA);
            PG8_BAR; PG8_WAIT_L(0); PG8_MMA(1, 0, At, B0); PG8_BAR; PG8_SCHED;
            PG8_STAGE(PG8_SB(1, 1), b3 + hstepB, voffB);
            PG8_WAIT_V(6); PG8_BAR; PG8_MMA(1, 1, At, B1); PG8_BAR;
        }
        E(acc, cur, wr, wc, fr, fq);
        if (!has_next) break;
#pragma unroll
        for (int a = 0; a < 2; ++a)
#pragma unroll
            for (int b = 0; b < 2; ++b)
#pragma unroll
                for (int m = 0; m < 4; ++m)
#pragma unroll
                    for (int n = 0; n < 2; ++n) acc[a][b][m][n] = (f32x4){0.f, 0.f, 0.f, 0.f};
        cur = nxt; cA = nA; cB = nB; ++ui;
    }
    PG8_WAIT_V(0);
    if (wr == 0) PG8_BAR;
    PG8_BAR;
#undef PG8_SA
#undef PG8_SB
#undef PG8_STAGE
#undef PG8_LDA
#undef PG8_LDB
#undef PG8_MMA
#undef PG8_WAIT_V
#undef PG8_WAIT_L
#undef PG8_BAR
#undef PG8_SCHED
}
}
using pg8::Unit;
typedef f32x4 Acc[2][2][4][2];

struct EpiSwiglu {
    bf16_t* H;
    __device__ __forceinline__ void operator()(const Acc& acc, const Unit& u, int wr, int wc, int fr, int fq) const {
        const int row0 = u.pm * 256 + wr * 64 + fr, col = u.pn * 128 + wc * 32 + 8 * fq;
#pragma unroll
        for (int ai = 0; ai < 2; ++ai)
#pragma unroll
            for (int m = 0; m < 4; ++m) {
                const int row = row0 + ai * 128 + m * 16;
                float h[8];
#pragma unroll
                for (int n = 0; n < 2; ++n)
#pragma unroll
                    for (int j = 0; j < 4; ++j) { const float a = acc[ai][0][m][n][j], b = acc[ai][1][m][n][j]; h[n * 4 + j] = a * sigmoidf_(a) * b; }
                u32x4 w; w.x = cvt_pk_bf16(h[0], h[1]); w.y = cvt_pk_bf16(h[2], h[3]); w.z = cvt_pk_bf16(h[4], h[5]); w.w = cvt_pk_bf16(h[6], h[7]);
                *(u32x4*)(H + (size_t)row * DFF + col) = w;
            }
    }
};
template <int XB> struct EpiResid {
    const float* xa; const float* xb; const float* mod; int gidx; float gs; bf16_t* out;
    __device__ __forceinline__ void operator()(const Acc& acc, const Unit& u, int wr, int wc, int fr, int fq) const {
        const int row0 = u.pm * 256 + wr * 64 + fr, col0 = u.pn * 256 + wc * 32 + 8 * fq;
        const int ci = u.pm < 32 ? 0 : 1 + ((u.pm - 32) >> 3);
        const float* gate = mod + (size_t)ci * NMOD + gidx * DM;
        const float* xbase = u.pm < 32 ? xa : xb;
#pragma unroll
        for (int bj = 0; bj < 2; ++bj) {
            const int col = col0 + bj * 128;
            const f32x4 g0 = ld4(gate + col) * gs, g1 = ld4(gate + col + 4) * gs;
            if (XB) {
                u32x4 xw[8];
#pragma unroll
                for (int r = 0; r < 8; ++r) xw[r] = *(const u32x4*)((const bf16_t*)xbase + (size_t)(row0 + (r >> 2) * 128 + (r & 3) * 16) * DM + col);
                __builtin_amdgcn_sched_barrier(0);
#pragma unroll
                for (int r = 0; r < 8; ++r) {
                    const size_t o = (size_t)(row0 + (r >> 2) * 128 + (r & 3) * 16) * DM + col;
                    const f32x4 xl = {bflo(xw[r].x), bfhi(xw[r].x), bflo(xw[r].y), bfhi(xw[r].y)}, xh = {bflo(xw[r].z), bfhi(xw[r].z), bflo(xw[r].w), bfhi(xw[r].w)};
                    stbf8(out + o, xl * ALPHA + g0 * acc[r >> 2][bj][r & 3][0], xh * ALPHA + g1 * acc[r >> 2][bj][r & 3][1]);
                }
                __builtin_amdgcn_sched_barrier(0);
            } else
#pragma unroll
            for (int ai = 0; ai < 2; ++ai) {
                f32x4 x0[4], x1[4];
#pragma unroll
                for (int m = 0; m < 4; ++m) {
                    const size_t o = (size_t)(row0 + ai * 128 + m * 16) * DM + col;
                    if (XB) { const u32x4 xw = *(const u32x4*)((const bf16_t*)xbase + o); x0[m] = (f32x4){bflo(xw.x), bfhi(xw.x), bflo(xw.y), bfhi(xw.y)}; x1[m] = (f32x4){bflo(xw.z), bfhi(xw.z), bflo(xw.w), bfhi(xw.w)}; }
                    else { x0[m] = ld4(xbase + o); x1[m] = ld4(xbase + o + 4); }
                }
                __builtin_amdgcn_sched_barrier(0);
#pragma unroll
                for (int m = 0; m < 4; ++m) {
                    const size_t o = (size_t)(row0 + ai * 128 + m * 16) * DM + col;
                    stbf8(out + o, x0[m] * ALPHA + g0 * acc[ai][bj][m][0], x1[m] * ALPHA + g1 * acc[ai][bj][m][1]);
                }
                __builtin_amdgcn_sched_barrier(0);
            }
        }
    }
};
template <int PART> struct EpiResidSplit {
    const float* x; const float* mod; bf16_t* out;
    __device__ __forceinline__ void operator()(const Acc& acc, const Unit& u, int wr, int wc, int fr, int fq) const {
        const int lrow0 = u.pm * 256 + wr * 64 + fr, col0 = u.pn * 256 + wc * 32 + 8 * fq;
        const float* gate = mod + (size_t)(1 + (u.pm >> 3)) * NMOD + 8 * DM;
#pragma unroll
        for (int bj = 0; bj < 2; ++bj) {
            const int col = col0 + bj * 128;
            const f32x4 g0 = ld4(gate + col) * 0.5f, g1 = ld4(gate + col + 4) * 0.5f;
#pragma unroll
            for (int ai = 0; ai < 2; ++ai) {
                u32x4 xw[4];
                if (PART == 0) {
#pragma unroll
                    for (int m = 0; m < 4; ++m) xw[m] = *(const u32x4*)((const bf16_t*)x + (size_t)(lrow0 + ai * 128 + m * 16 + 8192) * DM + col);
                    __builtin_amdgcn_sched_barrier(0);
                }
#pragma unroll
                for (int m = 0; m < 4; ++m) {
                    const size_t lo = (size_t)(lrow0 + ai * 128 + m * 16) * DM + col;
                    if (PART == 0) {
                        const size_t o = lo + (size_t)8192 * DM;
                        const f32x4 x0 = {bflo(xw[m].x), bfhi(xw[m].x), bflo(xw[m].y), bfhi(xw[m].y)}, x1 = {bflo(xw[m].z), bfhi(xw[m].z), bflo(xw[m].w), bfhi(xw[m].w)};
                        stbf8(out + o, x0 * ALPHA + g0 * acc[ai][bj][m][0], x1 * ALPHA + g1 * acc[ai][bj][m][1]);
                    } else {
                        stbf8(out + lo, g0 * acc[ai][bj][m][0], g1 * acc[ai][bj][m][1]);
                    }
                }
                __builtin_amdgcn_sched_barrier(0);
            }
        }
    }
};
struct EpiProj {
    bf16_t* zs; bf16_t* uv;
    __device__ __forceinline__ void operator()(const Acc& acc, const Unit& u, int wr, int wc, int fr, int fq) const {
        const int row0 = u.pm * 256 + wr * 64 + fr;
        if (u.pn < 14) {
#pragma unroll
            for (int bj = 0; bj < 2; ++bj) {
                const int col = u.pn * 256 + bj * 128 + wc * 32 + 8 * fq;
                if (col < NZS) {
#pragma unroll
                    for (int ai = 0; ai < 2; ++ai)
#pragma unroll
                        for (int m = 0; m < 4; ++m) {
                            const f32x4 v0 = acc[ai][bj][m][0], v1 = acc[ai][bj][m][1];
                            u32x4 w; w.x = cvt_pk_bf16(v0[0], v0[1]); w.y = cvt_pk_bf16(v0[2], v0[3]); w.z = cvt_pk_bf16(v1[0], v1[1]); w.w = cvt_pk_bf16(v1[2], v1[3]);
                            *(u32x4*)(zs + (size_t)(row0 + ai * 128 + m * 16) * NZS + col) = w;
                        }
                }
            }
        } else {
#pragma unroll
            for (int bj = 0; bj < 2; ++bj) {
                const int col = (u.pn - 14) * 256 + bj * 128 + wc * 32 + 8 * fq;
#pragma unroll
                for (int ai = 0; ai < 2; ++ai)
#pragma unroll
                    for (int m = 0; m < 4; ++m) {
                        const f32x4 v0 = acc[ai][bj][m][0], v1 = acc[ai][bj][m][1];
                        const f32x2 a = gelu_pk((f32x2){v0[0], v0[1]}), b = gelu_pk((f32x2){v0[2], v0[3]}), c = gelu_pk((f32x2){v1[0], v1[1]}), d = gelu_pk((f32x2){v1[2], v1[3]});
                        u32x4 w; w.x = cvt_pk_bf16(a.x, a.y); w.y = cvt_pk_bf16(b.x, b.y); w.z = cvt_pk_bf16(c.x, c.y); w.w = cvt_pk_bf16(d.x, d.y);
                        *(u32x4*)(uv + (size_t)(row0 + ai * 128 + m * 16) * 2048 + col) = w;
                    }
            }
        }
    }
};
struct EpiGates {
    bf16_t* gts;
    __device__ __forceinline__ void operator()(const Acc& acc, const Unit& u, int wr, int wc, int fr, int fq) const {
        const int row0 = u.pm * 256 + wr * 64 + fr;
#pragma unroll
        for (int bj = 0; bj < 2; ++bj) {
            const int col = u.pn * 256 + bj * 128 + wc * 32 + 8 * fq;
#pragma unroll
            for (int ai = 0; ai < 2; ++ai)
#pragma unroll
                for (int m = 0; m < 4; ++m) {
                    const f32x4 v0 = acc[ai][bj][m][0], v1 = acc[ai][bj][m][1];
                    u32x4 w; w.x = cvt_pk_bf16(sigmoidf_(v0[0]), sigmoidf_(v0[1])); w.y = cvt_pk_bf16(sigmoidf_(v0[2]), sigmoidf_(v0[3]));
                    w.z = cvt_pk_bf16(sigmoidf_(v1[0]), sigmoidf_(v1[1])); w.w = cvt_pk_bf16(sigmoidf_(v1[2]), sigmoidf_(v1[3]));
                    *(u32x4*)(gts + (size_t)(row0 + ai * 128 + m * 16) * 4096 + col) = w;
                }
        }
    }
};
struct EpiLora {
    float* dec; bf16_t* abf; bf16_t* gg; const float* w0; const float* a0;
    __device__ __forceinline__ void operator()(const Acc& acc, const Unit& u, int wr, int wc, int fr, int fq) const {
        const int row0 = u.pm * 256 + wr * 64 + fr;
        const int sec = u.pn >> 2;
        const float* bias = sec < 2 ? w0 + sec * 1024 : a0 + ((sec - 2) & 1) * 1024;
#pragma unroll
        for (int bj = 0; bj < 2; ++bj) {
            const int col = (u.pn & 3) * 256 + bj * 128 + wc * 32 + 8 * fq;
            f32x4 b0 = {0.f, 0.f, 0.f, 0.f}, b1 = b0;
            if (sec < 4) { b0 = ld4(bias + col); b1 = ld4(bias + col + 4); }
#pragma unroll
            for (int ai = 0; ai < 2; ++ai)
#pragma unroll
                for (int m = 0; m < 4; ++m) {
                    const size_t row = (size_t)(row0 + ai * 128 + m * 16);
                    const f32x4 v0 = acc[ai][bj][m][0] + b0, v1 = acc[ai][bj][m][1] + b1;
                    if (sec < 2) {
                        f32x4 o0, o1;
#pragma unroll
                        for (int j = 0; j < 4; ++j) { o0[j] = __expf(-0.6065306597f * sigmoidf_(v0[j])); o1[j] = __expf(-0.6065306597f * sigmoidf_(v1[j])); }
                        float* p = dec + ((size_t)sec * M_TOK + row) * 1024 + col;
                        st4(p, o0); st4(p + 4, o1);
                    } else {
                        f32x4 o0 = v0, o1 = v1;
                        if (sec < 4) {
#pragma unroll
                            for (int j = 0; j < 4; ++j) { o0[j] = sigmoidf_(v0[j]); o1[j] = sigmoidf_(v1[j]); }
                        }
                        u32x4 w; w.x = cvt_pk_bf16(o0[0], o0[1]); w.y = cvt_pk_bf16(o0[2], o0[3]); w.z = cvt_pk_bf16(o1[0], o1[1]); w.w = cvt_pk_bf16(o1[2], o1[3]);
                        bf16_t* dst = sec < 4 ? abf + ((size_t)(sec - 2) * M_TOK + row) * 1024 + col : gg + row * 1024 + col;
                        *(u32x4*)dst = w;
                    }
                    __builtin_amdgcn_sched_barrier(0);
                }
        }
    }
};
template <int SECOND> struct EpiMerge {
    const bf16_t* gts; float* m1; bf16_t* merged;
    __device__ __forceinline__ void operator()(const Acc& acc, const Unit& u, int wr, int wc, int fr, int fq) const {
        const int row0 = u.pm * 256 + wr * 64 + fr;
#pragma unroll
        for (int bj = 0; bj < 2; ++bj) {
            const int col = u.pn * 256 + bj * 128 + wc * 32 + 8 * fq;
            if (!SECOND) {
                u32x4 g8[8];
#pragma unroll
                for (int r = 0; r < 8; ++r) g8[r] = *(const u32x4*)(gts + (size_t)(row0 + (r >> 2) * 128 + (r & 3) * 16) * 4096 + col);
                __builtin_amdgcn_sched_barrier(0);
#pragma unroll
                for (int r = 0; r < 8; ++r) {
                    const size_t row = (size_t)(row0 + (r >> 2) * 128 + (r & 3) * 16);
                    const f32x4 g0 = {bflo(g8[r].x), bfhi(g8[r].x), bflo(g8[r].y), bfhi(g8[r].y)}, g1 = {bflo(g8[r].z), bfhi(g8[r].z), bflo(g8[r].w), bfhi(g8[r].w)};
                    stbf8(merged + row * DM + col, g0 * acc[r >> 2][bj][r & 3][0], g1 * acc[r >> 2][bj][r & 3][1]);
                }
                __builtin_amdgcn_sched_barrier(0);
            } else
#pragma unroll
            for (int ai = 0; ai < 2; ++ai) {
                u32x4 gw[4], pw[4];
#pragma unroll
                for (int m = 0; m < 4; ++m) {
                    const size_t row = (size_t)(row0 + ai * 128 + m * 16);
                    gw[m] = *(const u32x4*)(gts + row * 4096 + SECOND * 2048 + col);
                    if (SECOND) pw[m] = *(const u32x4*)(merged + row * DM + col);
                }
                __builtin_amdgcn_sched_barrier(0);
#pragma unroll
                for (int m = 0; m < 4; ++m) {
                    const size_t row = (size_t)(row0 + ai * 128 + m * 16);
                    const f32x4 g0 = {bflo(gw[m].x), bfhi(gw[m].x), bflo(gw[m].y), bfhi(gw[m].y)}, g1 = {bflo(gw[m].z), bfhi(gw[m].z), bflo(gw[m].w), bfhi(gw[m].w)};
                    f32x4 v0 = g0 * acc[ai][bj][m][0], v1 = g1 * acc[ai][bj][m][1];
                    if (SECOND) { v0 += (f32x4){bflo(pw[m].x), bfhi(pw[m].x), bflo(pw[m].y), bfhi(pw[m].y)}; v1 += (f32x4){bflo(pw[m].z), bfhi(pw[m].z), bflo(pw[m].w), bfhi(pw[m].w)}; }
                    stbf8(merged + row * DM + col, v0, v1);
                }
                __builtin_amdgcn_sched_barrier(0);
            }
        }
    }
};

template <int MODE> __device__ __forceinline__ int maprow(int n) {
    if (MODE == 1) { const int half = n >= DFF ? 1 : 0; const int i = n - half * DFF; return (i >> 7) * 256 + half * 128 + (i & 127); }
    if (MODE == 2) { return n < NZS ? n : n + 224; }
    return n;
}
template <int MODE> __device__ __forceinline__ void conv_T(const float* src, int K, int N, bf16_t* dst, unsigned char* lds, int b0, int nb) {
    const int tid = threadIdx.x, kg = tid >> 6, nq = tid & 63;
    const int nkt = K / 64, nnt = (N + 255) / 256, ntile = nkt * nnt;
    for (int t = (int)blockIdx.x - b0; t < ntile; t += nb) {
        const int kt = t % nkt, ntl = t / nkt, k0 = kt * 64 + kg * 8, n0 = ntl * 256 + nq * 4;
        f32x4 v[8];
#pragma unroll
        for (int i = 0; i < 8; ++i) { v[i] = (f32x4){0.f, 0.f, 0.f, 0.f}; if (n0 < N) v[i] = ld4(src + (size_t)(k0 + i) * N + n0); }
#pragma unroll
        for (int j = 0; j < 4; ++j) {
            u32x4 w; w.x = cvt_pk_bf16(v[0][j], v[1][j]); w.y = cvt_pk_bf16(v[2][j], v[3][j]); w.z = cvt_pk_bf16(v[4][j], v[5][j]); w.w = cvt_pk_bf16(v[6][j], v[7][j]);
            *(u32x4*)(lds + (nq * 4 + j) * 144 + kg * 16) = w;
        }
        __syncthreads();
        const int n = tid >> 1, kh = tid & 1, gn = ntl * 256 + n;
        if (gn < N) {
            bf16_t* d = dst + (size_t)maprow<MODE>(gn) * K + kt * 64 + kh * 32;
#pragma unroll
            for (int q = 0; q < 4; ++q) *(u32x4*)(d + q * 8) = *(const u32x4*)(lds + n * 144 + kh * 64 + q * 16);
        }
        __syncthreads();
    }
}

template <bool FINAL> __device__ __forceinline__ void ln_rows(const bf16_t* pre, const float* g, const float* b, float* xout, bf16_t* aout, const float* mod, int modi, const bf16_t* preB = nullptr) {
    const int lane = threadIdx.x & 63, gw = blockIdx.x * 8 + (threadIdx.x >> 6), nw = gridDim.x * 8;
    f32x4 gg[8], bb[8], v[8];
#pragma unroll
    for (int i = 0; i < 8; ++i) { gg[i] = ld4(g + i * 256 + lane * 4); bb[i] = ld4(b + i * 256 + lane * 4); v[i] = (f32x4){0.f, 0.f, 0.f, 0.f}; }
    if (gw < M_TOK) {
#pragma unroll
        for (int i = 0; i < 8; ++i) { v[i] = ldbf4(pre + (size_t)gw * DM + i * 256 + lane * 4); if (FINAL) { if (preB && gw >= 8192) v[i] += ldbf4(preB + (size_t)(gw - 8192) * DM + i * 256 + lane * 4); } }
    }
    for (int row = gw; row < M_TOK; row += nw) {
        const int nrow = row + nw;
        f32x4 vn[8], sc[8], sh[8];
#pragma unroll
        for (int i = 0; i < 8; ++i) vn[i] = (f32x4){0.f, 0.f, 0.f, 0.f};
        if (nrow < M_TOK) {
#pragma unroll
            for (int i = 0; i < 8; ++i) { vn[i] = ldbf4(pre + (size_t)nrow * DM + i * 256 + lane * 4); if (FINAL) { if (preB && nrow >= 8192) vn[i] += ldbf4(preB + (size_t)(nrow - 8192) * DM + i * 256 + lane * 4); } }
        }
        if (!FINAL) {
            const float* md = mod + (size_t)cond_of_row(row) * NMOD + (3 * modi) * DM;
#pragma unroll
            for (int i = 0; i < 8; ++i) { sc[i] = ld4(md + DM + i * 256 + lane * 4); sh[i] = ld4(md + i * 256 + lane * 4); }
        }
        float s = 0.f;
#pragma unroll
        for (int i = 0; i < 8; ++i) s += (v[i][0] + v[i][1]) + (v[i][2] + v[i][3]);
        const float mu = wsum(s) * (1.0f / DM);
        float q = 0.f;
#pragma unroll
        for (int i = 0; i < 8; ++i) { const f32x4 d = v[i] - mu; q += (d[0] * d[0] + d[1] * d[1]) + (d[2] * d[2] + d[3] * d[3]); }
        const float rstd = rsqrtf(wsum(q) * (1.0f / DM) + LN_EPS);
#pragma unroll
        for (int i = 0; i < 8; ++i) {
            const int c = i * 256 + lane * 4;
            const f32x4 x = (v[i] - mu) * rstd * gg[i] + bb[i];
            if (FINAL) st4(xout + (size_t)row * DM + c, x);
            else {
                u32x2 xw; xw.x = cvt_pk_bf16(x[0], x[1]); xw.y = cvt_pk_bf16(x[2], x[3]); *(u32x2*)((bf16_t*)xout + (size_t)row * DM + c) = xw;
                const f32x4 a = x * (sc[i] + 1.0f) + sh[i];
                u32x2 w; w.x = cvt_pk_bf16(a[0], a[1]); w.y = cvt_pk_bf16(a[2], a[3]);
                *(u32x2*)(aout + (size_t)row * DM + c) = w;
            }
        }
#pragma unroll
        for (int i = 0; i < 8; ++i) v[i] = vn[i];
    }
}

template <int CTRL> __device__ __forceinline__ float dpp_add(float x) {
    const int y = __builtin_amdgcn_update_dpp(0, __float_as_int(x), CTRL, 0xF, 0xF, true);
    return x + __int_as_float(y);
}
template <int L> __device__ __forceinline__ float redL(float x) {
    x = dpp_add<0xB1>(x); x = dpp_add<0x4E>(x);
    if (L >= 8) x = dpp_add<0x141>(x);
    if (L >= 16) x = dpp_add<0x140>(x);
    return x;
}
template <bool VC> __device__ __forceinline__ void scan_issue(LAS unsigned char* buf, const char* gdec, const char* gkk, const char* gk, const char* gr, const char* gv, const char* ga,
                                                              unsigned offF, unsigned offA, unsigned offV, int lane) {
    __builtin_amdgcn_global_load_lds((const unsigned*)(gdec + offF), (LAS unsigned*)(buf + 0), 16, 0, 0);
    __builtin_amdgcn_global_load_lds((const unsigned*)(gkk + offF), (LAS unsigned*)(buf + 1024), 16, 0, 0);
    __builtin_amdgcn_global_load_lds((const unsigned*)(gk + offF), (LAS unsigned*)(buf + 2048), 16, 0, 0);
    __builtin_amdgcn_global_load_lds((const unsigned*)(gr + offF), (LAS unsigned*)(buf + 3072), 16, 0, 0);
    if (!VC) __builtin_amdgcn_global_load_lds((const unsigned*)(gv + offF), (LAS unsigned*)(buf + 4608), 16, 0, 0);
    if (lane < 32) __builtin_amdgcn_global_load_lds((const unsigned*)(ga + offA), (LAS unsigned*)(buf + 4096), 16, 0, 0);
    if (VC) { if (lane < 4) __builtin_amdgcn_global_load_lds((const unsigned*)(gv + offV), (LAS unsigned*)(buf + 4608), 16, 0, 0); }
}
template <int RR, int L, int NB, bool VC>
__device__ __forceinline__ void scan_run(const unsigned char* ws, const float* rw_k_a, LAS unsigned char* wl, LAS unsigned char* ys, int tok0, int T, int h, int d, int rowbase,
                                         const float* S0, float* Sout, int lane) {
    constexpr int E = 64 / L, E4 = E / 4, E2 = E / 2, OBB = VC ? 4672 : 5632, BUFB = OBB + 1024, D = NB - 1;
    const int cs = lane % L, rg = lane / L, row0 = rowbase + rg * RR, c0 = cs * E;
    f32x2 S[RR][E2];
#pragma unroll
    for (int i = 0; i < RR; ++i)
#pragma unroll
        for (int e = 0; e < E2; ++e) {
            if (S0) { S[i][e].x = S0[(row0 + i) * 64 + c0 + 2 * e]; S[i][e].y = S0[(row0 + i) * 64 + c0 + 2 * e + 1]; }
            else { S[i][e].x = 0.f; S[i][e].y = 0.f; }
        }
    const float kal = rw_k_a[h * 64 + lane], okal = 1.0f - kal;
    const char* gdec = (const char*)((const float*)(ws + O_DEC) + (size_t)d * M_TOK * 1024 + h * 64);
    const char* gkk = (const char*)((const float*)(ws + O_KK) + h * 64);
    const char* gk = (const char*)((const float*)(ws + O_K) + h * 64);
    const char* gr = (const char*)((const float*)(ws + O_R) + h * 64);
    const char* gv = (const char*)((const float*)(ws + O_V) + h * 64);
    const char* ga = (const char*)((const bf16_t*)(ws + O_ABF) + (size_t)d * M_TOK * 1024 + h * 64);
    unsigned offF, offA, offV;
    { const int s = lane >> 4, t = d ? T - 1 - s : s; offF = (unsigned)(((tok0 + t) * 1024 + (lane & 15) * 4) * 4); }
    { const int s = (lane >> 3) & 3, t = d ? T - 1 - s : s; offA = (unsigned)(((tok0 + t) * 1024 + (lane & 7) * 8) * 2); }
    { const int s = lane & 3, t = d ? T - 1 - s : s; offV = (unsigned)(((tok0 + t) * 1024 + rowbase) * 4); }
    const unsigned dF = d ? (unsigned)(-16384) : 16384u, dA = d ? (unsigned)(-8192) : 8192u;
    bf16_t* gy = (bf16_t*)(ws + O_Y) + (size_t)d * M_TOK * 1024 + h * 64;
    const int nc = T / 4;
    asm volatile("s_waitcnt vmcnt(0)" ::: "memory");
#pragma unroll
    for (int c = 0; c < D; ++c) { scan_issue<VC>(wl + c * BUFB, gdec, gkk, gk, gr, gv, ga, offF, offA, offV, lane); offF += dF; offA += dA; offV += dF; }
    int bi = 0;
    for (int c = 0; c < nc; ++c) {
        if (c + D <= nc) {
            if (D == 1) asm volatile("s_waitcnt vmcnt(0)" ::: "memory");
            else if (D == 2) asm volatile("s_waitcnt vmcnt(6)" ::: "memory");
            else if (D == 3) asm volatile("s_waitcnt vmcnt(12)" ::: "memory");
            else asm volatile("s_waitcnt vmcnt(18)" ::: "memory");
        } else asm volatile("s_waitcnt vmcnt(0)" ::: "memory");
        if (VC ? ((c & 15) == 0 && c > 0) : (c > 0)) {
            const int i = VC ? (c - 16) * 4 + lane : (c - 1) * 4 + (lane >> 4), t = d ? T - 1 - i : i;
            const u32x2 yv = *(const LAS u32x2*)(ys + lane * 8);
            *(u32x2*)(gy + (size_t)(tok0 + t) * 1024 + (VC ? rowbase : (lane & 15) * 4)) = yv;
        }
        if (c + D < nc) { int bn = bi + D; if (bn >= NB) bn -= NB; scan_issue<VC>(wl + bn * BUFB, gdec, gkk, gk, gr, gv, ga, offF, offA, offV, lane); offF += dF; offA += dA; offV += dF; }
        LAS unsigned char* b = wl + bi * BUFB;
        if (++bi == NB) bi = 0;
#pragma unroll
        for (int s = 0; s < 4; ++s) {
            const float kkv = *(const LAS float*)(b + 1024 + s * 256 + lane * 4);
            const float kv = *(const LAS float*)(b + 2048 + s * 256 + lane * 4);
            const float av = __uint_as_float(((unsigned)*(const LAS unsigned short*)(b + 4096 + s * 128 + lane * 2)) << 16);
            *(LAS float*)(b + OBB + s * 256 + lane * 4) = kkv * av;
            *(LAS float*)(b + 2048 + s * 256 + lane * 4) = kv * (av * kal + okal);
        }
        asm volatile("s_waitcnt lgkmcnt(0)" ::: "memory");
#define SCAN_STEP(W_, KK_, KD_, R_, BB_, VI_, s_) do { \
            float yo[RR]; \
            _Pragma("unroll") for (int ri = 0; ri < RR; ++ri) { \
                const float vi = (VI_)[ri]; \
                f32x2 acc2 = {0.f, 0.f}; \
                _Pragma("unroll") for (int e = 0; e < E2; ++e) { const f32x2 kk2 = {(KK_)[e >> 1][(e & 1) * 2], (KK_)[e >> 1][(e & 1) * 2 + 1]}; acc2 = S[ri][e] * kk2 + acc2; } \
                const float sa = redL<L>(acc2.x + acc2.y); \
                f32x2 y2 = {0.f, 0.f}; \
                _Pragma("unroll") for (int e = 0; e < E2; ++e) { \
                    const f32x2 kd2 = {(KD_)[e >> 1][(e & 1) * 2], (KD_)[e >> 1][(e & 1) * 2 + 1]}, bb2 = {(BB_)[e >> 1][(e & 1) * 2], (BB_)[e >> 1][(e & 1) * 2 + 1]}; \
                    const f32x2 w2 = {(W_)[e >> 1][(e & 1) * 2], (W_)[e >> 1][(e & 1) * 2 + 1]}, r2 = {(R_)[e >> 1][(e & 1) * 2], (R_)[e >> 1][(e & 1) * 2 + 1]}; \
                    const f32x2 tt = kd2 * vi - bb2 * sa; \
                    S[ri][e] = S[ri][e] * w2 + tt; \
                    y2 = S[ri][e] * r2 + y2; \
                } \
                yo[ri] = redL<L>(y2.x + y2.y); \
            } \
            if (cs == 0) {   \
                if (RR == 4) { u32x2 pk; pk.x = cvt_pk_bf16(yo[0], yo[1]); pk.y = cvt_pk_bf16(yo[2], yo[RR - 1]); *(LAS u32x2*)(ys + ((s_) * 16 + rg) * 8) = pk; } \
                else *(LAS bf16_t*)(ys + (((c & 15) * 4 + (s_)) * 8) + rg * 2) = (bf16_t)(cvt_pk_bf16(yo[0], yo[0]) & 0xffffu); \
            } } while (0)
        if constexpr (VC) {
            f32x4 W[4][E4], KK[4][E4], KD[4][E4], R[4][E4], BB[4][E4]; float VI[4][RR];
#pragma unroll
            for (int s = 0; s < 4; ++s) {
#pragma unroll
                for (int e = 0; e < E4; ++e) {
                    W[s][e] = *(const LAS f32x4*)(b + 0 + s * 256 + c0 * 4 + e * 16);
                    KK[s][e] = *(const LAS f32x4*)(b + 1024 + s * 256 + c0 * 4 + e * 16);
                    KD[s][e] = *(const LAS f32x4*)(b + 2048 + s * 256 + c0 * 4 + e * 16);
                    R[s][e] = *(const LAS f32x4*)(b + 3072 + s * 256 + c0 * 4 + e * 16);
                    BB[s][e] = *(const LAS f32x4*)(b + OBB + s * 256 + c0 * 4 + e * 16);
                }
#pragma unroll
                for (int ri = 0; ri < RR; ++ri) VI[s][ri] = *(const LAS float*)(b + 4608 + s * 16 + (row0 + ri - rowbase) * 4);
            }
            asm volatile("s_waitcnt lgkmcnt(0)" ::: "memory");
            float yp4[4];
#pragma unroll
            for (int s = 0; s < 4; ++s) {
                const f32x2 kkA = {KK[s][0][0], KK[s][0][1]}, kkB = {KK[s][0][2], KK[s][0][3]};
                const f32x2 acc2 = S[0][1] * kkB + S[0][0] * kkA;
                const float sa = redL<L>(acc2.x + acc2.y);
                const float vi = VI[s][0];
                const f32x2 kdA = {KD[s][0][0], KD[s][0][1]}, kdB = {KD[s][0][2], KD[s][0][3]}, bbA = {BB[s][0][0], BB[s][0][1]}, bbB = {BB[s][0][2], BB[s][0][3]};
                const f32x2 wA = {W[s][0][0], W[s][0][1]}, wB = {W[s][0][2], W[s][0][3]}, rA = {R[s][0][0], R[s][0][1]}, rB = {R[s][0][2], R[s][0][3]};
                const f32x2 uA = kdA * vi, uB = kdB * vi;
                S[0][0] = S[0][0] * wA + (uA - bbA * sa);
                S[0][1] = S[0][1] * wB + (uB - bbB * sa);
                const f32x2 y2 = S[0][1] * rB + S[0][0] * rA;
                yp4[s] = y2.x + y2.y;
            }
#pragma unroll
            for (int s = 0; s < 4; ++s) yp4[s] = redL<L>(yp4[s]);
            if (cs == 0) {
                u32x2 pk; pk.x = cvt_pk_bf16(yp4[0], yp4[1]); pk.y = cvt_pk_bf16(yp4[2], yp4[3]);
                LAS bf16_t* yq = (LAS bf16_t*)(ys + ((c & 15) * 4) * 8 + rg * 2);
                yq[0] = (bf16_t)(pk.x & 0xffffu); yq[4] = (bf16_t)(pk.x >> 16); yq[8] = (bf16_t)(pk.y & 0xffffu); yq[12] = (bf16_t)(pk.y >> 16);
            }
        } else {
#pragma unroll 2
            for (int s = 0; s < 4; ++s) {
                f32x4 w[E4], kk[E4], kd[E4], r[E4], bb[E4]; float vv[RR];
#pragma unroll
                for (int e = 0; e < E4; ++e) {
                    w[e] = *(const LAS f32x4*)(b + 0 + s * 256 + c0 * 4 + e * 16);
                    kk[e] = *(const LAS f32x4*)(b + 1024 + s * 256 + c0 * 4 + e * 16);
                    kd[e] = *(const LAS f32x4*)(b + 2048 + s * 256 + c0 * 4 + e * 16);
                    r[e] = *(const LAS f32x4*)(b + 3072 + s * 256 + c0 * 4 + e * 16);
                    bb[e] = *(const LAS f32x4*)(b + OBB + s * 256 + c0 * 4 + e * 16);
                }
#pragma unroll
                for (int ri = 0; ri < RR; ++ri) vv[ri] = *(const LAS float*)(b + 4608 + s * 256 + (row0 + ri) * 4);
                SCAN_STEP(w, kk, kd, r, bb, vv, s);
            }
        }
#undef SCAN_STEP
    }
    {
        const int i = VC ? (nc - 16) * 4 + lane : (nc - 1) * 4 + (lane >> 4), t = d ? T - 1 - i : i;
        const u32x2 yv = *(const LAS u32x2*)(ys + lane * 8);
        *(u32x2*)(gy + (size_t)(tok0 + t) * 1024 + (VC ? rowbase : (lane & 15) * 4)) = yv;
    }
    if (Sout) {
#pragma unroll
        for (int i = 0; i < RR; ++i)
#pragma unroll
            for (int e = 0; e < E2; ++e) *(f32x2*)(Sout + (row0 + i) * 64 + c0 + 2 * e) = S[i][e];
    }
    asm volatile("s_waitcnt vmcnt(0)" ::: "memory");
}


#define XB_TMO      128
#define XB_XCNT(j)  (256  + 64 * (j))
#define XB_XSUB(j)  (1280 + 64 * (j))
#define XB_XGEN(j)  (2304 + 64 * (j))
#define XB_TOP      3328
#define XB_TOPGEN   3392
#define XCD_BAR_WORDS 3456
#define XB_SPIN_CAP (1u << 18)
__device__ __forceinline__ unsigned xb_ld(unsigned* p)              { return __hip_atomic_load(p, __ATOMIC_RELAXED, __HIP_MEMORY_SCOPE_AGENT); }
__device__ __forceinline__ unsigned xb_add(unsigned* p, unsigned v) { return __hip_atomic_fetch_add(p, v, __ATOMIC_RELAXED, __HIP_MEMORY_SCOPE_AGENT); }
__device__ __forceinline__ unsigned xb_xcc_id() { return (unsigned)__builtin_amdgcn_s_getreg((3 << 11) | 20) & 0xFu; }
#define XB_SPIN(cond, bar) do { unsigned _sp = 0; while (cond) { __builtin_amdgcn_s_sleep(1); \
    if ((++_sp & 255u) == 0u) { if (xb_ld(&(bar)[XB_TMO])) break; if (_sp > XB_SPIN_CAP) { atomicAdd(&(bar)[XB_TMO], 1u); break; } } } } while (0)
struct XcdBarrier { unsigned* bar; unsigned x; volatile LAS unsigned* st; };
__device__ __forceinline__ XcdBarrier xcd_barrier_post(unsigned* bar, volatile LAS unsigned* st) {
    XcdBarrier b; b.bar = bar; b.x = xb_xcc_id(); b.st = st;
    if (threadIdx.x == 0) (void)xb_add(&bar[XB_XCNT(b.x)], 1u);
    return b;
}
__device__ __forceinline__ void xcd_barrier_complete(unsigned* bar, unsigned x, unsigned& nloc, unsigned& nx) {
    const unsigned G = gridDim.x * gridDim.y * gridDim.z;
    unsigned sum, cnt, mine, sp = 0u;
    for (;;) {
        sum = 0u; cnt = 0u; mine = 0u;
#pragma unroll
        for (unsigned j = 0; j < 16; ++j) { const unsigned c = xb_ld(&bar[XB_XCNT(j)]); sum += c; cnt += (c > 0u) ? 1u : 0u; mine = (j == x) ? c : mine; }
        if (sum == G) break;
        __builtin_amdgcn_s_sleep(1);
        if ((++sp & 255u) == 0u) { if (xb_ld(&bar[XB_TMO])) break; if (sp > XB_SPIN_CAP) { atomicAdd(&bar[XB_TMO], 1u); break; } }
    }
    nloc = mine > 0u ? mine : 1u; nx = cnt > 0u ? cnt : 1u;
}
__device__ __forceinline__ void xcd_barrier(const XcdBarrier& b) {
    asm volatile("s_waitcnt vmcnt(0)" ::: "memory");
    __syncthreads();
    if (threadIdx.x == 0) {
        unsigned* bar = b.bar;
        __builtin_amdgcn_s_waitcnt(0);
        unsigned nloc = b.st[0], nx = b.st[1];
        if (nloc == 0u) { xcd_barrier_complete(bar, b.x, nloc, nx); b.st[0] = nloc; b.st[1] = nx; }
        const unsigned old = xb_add(&bar[XB_XSUB(b.x)], 1u);
        const unsigned gen = old / nloc;
        if (old + 1u == (gen + 1u) * nloc) {
            __builtin_amdgcn_fence(__ATOMIC_RELEASE, "agent");
            asm volatile("s_waitcnt vmcnt(0)" ::: "memory");
            const unsigned og = xb_add(&bar[XB_TOP], 1u);
            const unsigned tg = og / nx;
            if (og + 1u == (tg + 1u) * nx) xb_add(&bar[XB_TOPGEN], 1u);
            else XB_SPIN(xb_ld(&bar[XB_TOPGEN]) == tg, bar);
            __builtin_amdgcn_fence(__ATOMIC_ACQUIRE, "agent");
            xb_add(&bar[XB_XGEN(b.x)], 1u);
            asm volatile("s_waitcnt vmcnt(0)" ::: "memory");
        } else {
            XB_SPIN(xb_ld(&bar[XB_XGEN(b.x)]) == gen, bar);
            __builtin_amdgcn_fence(__ATOMIC_ACQUIRE, "agent");
            asm volatile("s_waitcnt vmcnt(0)" ::: "memory");
        }
    }
    __syncthreads();
}
constexpr size_t O_BAR = 229376;
constexpr int LDS_XB = 132096;

extern __shared__ __attribute__((aligned(16))) unsigned char shm[];

template <int ph> __device__ __forceinline__ void run_phase(const Params& p) {
    const int tid = threadIdx.x, lane = tid & 63, wid = tid >> 6;
    unsigned char* ws = p.ws;
    LAS unsigned char* lds = (LAS unsigned char*)shm;
    float* mod = (float*)(ws + O_MOD);
    {
        switch (ph) {
        case 0: {
            float* sc = (float*)shm;
            float* red = (float*)(shm + 24576);
            for (int i = tid; i < 3 * DM; i += 512) {
                const int ci = i / DM, k = i % DM;
                const float cv = ci == 0 ? p.in[5][k] : p.in[2][(ci - 1) * DM + k];
                sc[i] = cv * sigmoidf_(cv);
            }
            __syncthreads();
            for (int item = blockIdx.x; item < NMOD / 64; item += gridDim.x) {
                const int j0 = item * 64, jq = tid & 15, ks = tid >> 4;
                f32x4 a0 = {0.f, 0.f, 0.f, 0.f}, a1 = a0, a2 = a0;
                const float* wp = p.in[6] + (size_t)(ks * 64) * NMOD + j0 + jq * 4;
#pragma unroll 16
                for (int k = 0; k < 64; ++k) {
                    const f32x4 w = ld4(wp + (size_t)k * NMOD);
                    a0 += w * sc[ks * 64 + k]; a1 += w * sc[DM + ks * 64 + k]; a2 += w * sc[2 * DM + ks * 64 + k];
                }
                st4(red + ((ks * 3 + 0) * 16 + jq) * 4, a0); st4(red + ((ks * 3 + 1) * 16 + jq) * 4, a1); st4(red + ((ks * 3 + 2) * 16 + jq) * 4, a2);
                __syncthreads();
                if (tid < 48) {
                    const int ci = tid >> 4, q = tid & 15;
                    f32x4 s = ld4(p.in[7] + j0 + q * 4);
                    for (int k2 = 0; k2 < 32; ++k2) s += ld4(red + ((k2 * 3 + ci) * 16 + q) * 4);
                    st4(mod + (size_t)ci * NMOD + j0 + q * 4, s);
                }
                __syncthreads();
            }
            conv_T<1>(p.in[10], DM, 2 * DFF, (bf16_t*)(ws + WF_IN), shm, 0, gridDim.x);
            conv_T<0>(p.in[11], DFF, DM, (bf16_t*)(ws + WF_OUT), shm, 0, gridDim.x);
        } break;
        case 1: {
            bf16_t* A = (bf16_t*)(ws + O_ABUF);
            const size_t ngrp = (size_t)M_TOK * 256, stride = (size_t)gridDim.x * 512;
            for (size_t g0 = (size_t)blockIdx.x * 512 + tid; g0 < ngrp; g0 += 4 * stride) {
                f32x4 xa[4], xb[4];
#pragma unroll
                for (int j = 0; j < 4; ++j) {
                    const size_t gidx = g0 + j * stride;
                    xa[j] = (f32x4){0.f, 0.f, 0.f, 0.f}; xb[j] = xa[j];
                    if (gidx < ngrp) {
                        const int row = (int)(gidx >> 8), c = (int)(gidx & 255) * 8;
                        const float* x = row < M_CTX ? p.in[0] + (size_t)row * DM : p.in[1] + (size_t)(row - M_CTX) * DM;
                        xa[j] = ld4(x + c); xb[j] = ld4(x + c + 4);
                    }
                }
#pragma unroll
                for (int j = 0; j < 4; ++j) {
                    const size_t gidx = g0 + j * stride;
                    if (gidx < ngrp) {
                        const int row = (int)(gidx >> 8), c = (int)(gidx & 255) * 8;
                        const float* md = mod + (size_t)cond_of_row(row) * NMOD;
                        const f32x4 v0 = xa[j] * (ld4(md + DM + c) + 1.0f) + ld4(md + c), v1 = xb[j] * (ld4(md + DM + c + 4) + 1.0f) + ld4(md + c + 4);
                        u32x4 w; w.x = cvt_pk_bf16(v0[0], v0[1]); w.y = cvt_pk_bf16(v0[2], v0[3]); w.z = cvt_pk_bf16(v1[0], v1[1]); w.w = cvt_pk_bf16(v1[2], v1[3]);
                        *(u32x4*)(A + (size_t)row * DM + c) = w;
                    }
                }
            }
        } break;
        case 2: case 14: {
            pg8::Gemm g{(const bf16_t*)(ws + O_ABUF), (const bf16_t*)(ws + (ph == 14 ? WF2_IN : WF_IN)), M_TOK, 2 * DFF, DM, DM};
            pg8::StaticOrder S; S.init(M_TOK, 2 * DFF, gridDim.x, blockIdx.x);
            EpiSwiglu E{(bf16_t*)(ws + O_HID)};
            pg8::gemm_phase(lds, g, S, E);
        } break;
        case 3: case 12: case 15: {
            pg8::Gemm g; EpiResid<(ph != 3)> E;
            if (ph == 12) {
                g = pg8::Gemm{(const bf16_t*)(ws + O_ABUF), (const bf16_t*)(ws + WM_O), M_TOK, DM, DM, DM};
                E = EpiResid<(ph != 3)>{(const float*)(ws + O_XRES), (const float*)(ws + O_XRES), mod, 5, 1.0f, (bf16_t*)(ws + O_M1)};
            } else {
                g = pg8::Gemm{(const bf16_t*)(ws + O_HID), (const bf16_t*)(ws + (ph == 15 ? WF2_OUT : WF_OUT)), M_TOK, DM, DFF, DFF};
                if (ph == 3) E = EpiResid<(ph != 3)>{p.in[0], p.in[1] - (size_t)M_CTX * DM, mod, 2, 0.5f, (bf16_t*)(ws + O_PRE)};
                else E = EpiResid<(ph != 3)>{(const float*)(ws + O_XRES), (const float*)(ws + O_XRES), mod, 8, 0.5f, (bf16_t*)(ws + O_PRE)};
            }
            if (ph == 15 && gridDim.x == 256) {
                { g.M = 8192; pg8::StaticOrder S1; S1.init(8192, DM, 256, blockIdx.x); pg8::gemm_phase(lds, g, S1, E); }
                pg8::StaticOrder S2; S2.init(4096, DM, 128, blockIdx.x & 127);
                if (blockIdx.x < 128) {
                    pg8::Gemm g2{(const bf16_t*)(ws + O_HID) + (size_t)8192 * DFF, (const bf16_t*)(ws + WF2_OUT), 4096, DM, 2816, DFF, DFF};
                    EpiResidSplit<0> E2{(const float*)(ws + O_XRES), mod, (bf16_t*)(ws + O_PRE)};
                    pg8::gemm_phase(lds, g2, S2, E2);
                } else {
                    pg8::Gemm g2{(const bf16_t*)(ws + O_HID) + (size_t)8192 * DFF + 2816, (const bf16_t*)(ws + WF2_OUT) + 2816, 4096, DM, 2688, DFF, DFF};
                    EpiResidSplit<1> E2{(const float*)(ws + O_XRES), mod, (bf16_t*)(ws + O_PREB)};
                    pg8::gemm_phase(lds, g2, S2, E2);
                }
            } else {
            pg8::StaticOrder S; S.init(M_TOK, DM, gridDim.x, blockIdx.x);
            pg8::gemm_phase(lds, g, S, E);
            }
            if (ph == 3 || ph == 12) {
                int i0 = 384 - (int)gridDim.x; if (i0 < 0 || i0 >= (int)gridDim.x) i0 = 0;
                if ((int)blockIdx.x >= i0) {
                    __syncthreads();
                    if (ph == 3) {
                        conv_T<2>(p.in[12], DM, 9504, (bf16_t*)(ws + WM_IN), shm, i0, gridDim.x - i0);
                        conv_T<0>(p.in[28], DA, DM, (bf16_t*)(ws + WM_PA), shm, i0, gridDim.x - i0);
                    } else conv_T<0>(p.in[11] + (size_t)DFF * DM, DFF, DM, (bf16_t*)(ws + WF2_OUT), shm, i0, gridDim.x - i0);
                }
            }
        } break;
        case 4: case 13: case 16: {
            const int li = ph == 4 ? 0 : ph == 13 ? 1 : 2;
            const bf16_t* pre = (const bf16_t*)(ws + (ph == 13 ? O_M1 : O_PRE));
            if (ph == 16) ln_rows<true>(pre, p.in[8] + li * DM, p.in[9] + li * DM, p.out, nullptr, mod, 0, gridDim.x == 256 ? (const bf16_t*)(ws + O_PREB) : nullptr);
            else ln_rows<false>(pre, p.in[8] + li * DM, p.in[9] + li * DM, (float*)(ws + O_XRES), (bf16_t*)(ws + O_ABUF), mod, li + 1);
            if (ph == 4) {
                conv_T<0>(p.in[29], DA, DM, (bf16_t*)(ws + WM_PB), shm, 0, gridDim.x);
                conv_T<0>(p.in[30], DM, DM, (bf16_t*)(ws + WM_O), shm, 0, gridDim.x);
                bf16_t* wl = (bf16_t*)(ws + WM_L);
                for (int idx = blockIdx.x * 512 + tid; idx < 5120 * 48; idx += gridDim.x * 512) {
                    const int n = idx % 5120, kc = (idx / 5120) * 8, sec = n >> 10, c = n & 1023;
                    float v[8];
#pragma unroll
                    for (int j = 0; j < 8; ++j) {
                        const int k = kc + j; float x = 0.f;
                        if (sec < 2) { if (k < 64) x = p.in[15][((size_t)sec * 64 + k) * 1024 + c]; }
                        else if (sec < 4) { if (k >= 64 && k < 128) x = p.in[17][((size_t)(sec - 2) * 64 + (k - 64)) * 1024 + c]; }
                        else { if (k >= 128 && k < 288) x = p.in[18][(size_t)(k - 128) * 1024 + c]; }
                        v[j] = x;
                    }
                    u32x4 w; w.x = cvt_pk_bf16(v[0], v[1]); w.y = cvt_pk_bf16(v[2], v[3]); w.z = cvt_pk_bf16(v[4], v[5]); w.w = cvt_pk_bf16(v[6], v[7]);
                    *(u32x4*)(wl + (size_t)n * KL + kc) = w;
                }
            }
        } break;
        case 5: {
            pg8::Gemm g{(const bf16_t*)(ws + O_ABUF), (const bf16_t*)(ws + WM_IN), M_TOK, 5632, DM, DM};
            pg8::StaticOrder S; S.init(M_TOK, 5632, gridDim.x, blockIdx.x);
            EpiProj E{(bf16_t*)(ws + O_ZS), (bf16_t*)(ws + O_UV)};
            pg8::gemm_phase(lds, g, S, E);
        } break;
        case 6: {
            const bf16_t* zs = (const bf16_t*)(ws + O_ZS); const float* mu = p.in[13];
            float* R = (float*)(ws + O_R); float* Kq = (float*)(ws + O_K); float* V = (float*)(ws + O_V); float* KK = (float*)(ws + O_KK);
            bf16_t* LB = (bf16_t*)(ws + O_LB); bf16_t* UV = (bf16_t*)(ws + O_UV);
            for (int row = blockIdx.x * 8 + wid; row < M_TOK; row += gridDim.x * 8) {
                const bool lat = row >= M_CTX;
                int r0, r1, r2 = row, r3 = row; float f0, f1, f2 = 0.f, f3 = 0.f, wgt;
                if (!lat) { const int t = row & 255; r0 = t > 0 ? row - 1 : row; f0 = t > 0 ? 1.f : 0.f; r1 = t < 255 ? row + 1 : row; f1 = t < 255 ? 1.f : 0.f; wgt = 0.5f; }
                else {
                    const int q = (row - M_CTX) & 2047, gr = q >> 6, gc = q & 63;
                    r0 = gr > 0 ? row - 64 : row; f0 = gr > 0 ? 1.f : 0.f; r1 = gr < 31 ? row + 64 : row; f1 = gr < 31 ? 1.f : 0.f;
                    r2 = gc > 0 ? row - 1 : row; f2 = gc > 0 ? 1.f : 0.f; r3 = gc < 63 ? row + 1 : row; f3 = gc < 63 ? 1.f : 0.f; wgt = 0.25f;
                }
                const bf16_t* z = zs + (size_t)row * NZS; const bf16_t* z0 = zs + (size_t)r0 * NZS; const bf16_t* z1 = zs + (size_t)r1 * NZS;
                const bf16_t* z2 = zs + (size_t)r2 * NZS; const bf16_t* z3 = zs + (size_t)r3 * NZS;
#define SHIFT4(col, res) do { const f32x4 zz = ldbf4(z + (col)); f32x4 nb = ldbf4(z0 + (col)) * f0 + ldbf4(z1 + (col)) * f1; \
                    if (lat) nb += ldbf4(z2 + (col)) * f2 + ldbf4(z3 + (col)) * f3; nb *= wgt; res = zz + ld4(mu + (col)) * (nb - zz); } while (0)
                f32x4 rv[4], kv[4], vv[4]; float ss = 0.f;
                shift16(z, z0, z1, z2, z3, mu, lane * 16, lat, f0, f1, f2, f3, wgt, rv);
                shift16(z, z0, z1, z2, z3, mu, 1024 + lane * 16, lat, f0, f1, f2, f3, wgt, kv);
                shift16(z, z0, z1, z2, z3, mu, 2048 + lane * 16, lat, f0, f1, f2, f3, wgt, vv);
                f32x4 xlo = {0.f, 0.f, 0.f, 0.f}, xgg = xlo;
                if (lane < 32) SHIFT4(3072 + lane * 4, xlo);
                if (lane < 40) SHIFT4(3200 + lane * 4, xgg);
                bf16_t* vp = UV + (size_t)row * 2048 + 1024 + lane * 16;
                const u32x4 w0 = *(const u32x4*)vp, w1 = *(const u32x4*)(vp + 8);
                f32x4 lg[4], lb4[4];
#pragma unroll
                for (int q = 0; q < 4; ++q) { lg[q] = ld4(p.in[24] + lane * 16 + q * 4); lb4[q] = ld4(p.in[25] + lane * 16 + q * 4); }
                __builtin_amdgcn_sched_barrier(0);
#pragma unroll
                for (int q = 0; q < 4; ++q) {
                    const int c = lane * 16 + q * 4;
                    st4(R + (size_t)row * 1024 + c, rv[q]); st4(Kq + (size_t)row * 1024 + c, kv[q]); st4(V + (size_t)row * 1024 + c, vv[q]);
                    const f32x4 kq = kv[q] * ld4(p.in[19] + c);
                    kv[q] = kq; ss += (kq[0] * kq[0] + kq[1] * kq[1]) + (kq[2] * kq[2] + kq[3] * kq[3]);
                }
                ss += __shfl_xor(ss, 1); ss += __shfl_xor(ss, 2);
                const float inv = 1.0f / fmaxf(sqrtf(ss), 1e-12f);
#pragma unroll
                for (int q = 0; q < 4; ++q) st4(KK + (size_t)row * 1024 + lane * 16 + q * 4, kv[q] * inv);
                if (lane < 32) {
                    f32x4 x = xlo;
                    if (lane < 16) { x[0] = tanhf(x[0]); x[1] = tanhf(x[1]); x[2] = tanhf(x[2]); x[3] = tanhf(x[3]); }
                    u32x2 w; w.x = cvt_pk_bf16(x[0], x[1]); w.y = cvt_pk_bf16(x[2], x[3]);
                    *(u32x2*)(LB + (size_t)row * KL + lane * 4) = w;
                }
                if (lane < 40) {
                    const f32x4 x = xgg;
                    u32x2 w; w.x = cvt_pk_bf16(sigmoidf_(x[0]), sigmoidf_(x[1])); w.y = cvt_pk_bf16(sigmoidf_(x[2]), sigmoidf_(x[3]));
                    *(u32x2*)(LB + (size_t)row * KL + 128 + lane * 4) = w;
                } else { u32x2 w; w.x = 0u; w.y = 0u; *(u32x2*)(LB + (size_t)row * KL + 288 + (lane - 40) * 4) = w; }
#undef SHIFT4
                {
                    float x[16] = {bflo(w0.x), bfhi(w0.x), bflo(w0.y), bfhi(w0.y), bflo(w0.z), bfhi(w0.z), bflo(w0.w), bfhi(w0.w),
                                   bflo(w1.x), bfhi(w1.x), bflo(w1.y), bfhi(w1.y), bflo(w1.z), bfhi(w1.z), bflo(w1.w), bfhi(w1.w)};
                    float s = 0.f;
#pragma unroll
                    for (int j = 0; j < 16; ++j) s += x[j];
                    const float m = wsum(s) * (1.0f / 1024.f);
                    float qq = 0.f;
#pragma unroll
                    for (int j = 0; j < 16; ++j) { const float dd = x[j] - m; qq += dd * dd; }
                    const float rstd = rsqrtf(wsum(qq) * (1.0f / 1024.f) + LN_EPS);
                    float o[16];
#pragma unroll
                    for (int j = 0; j < 16; ++j) o[j] = (x[j] - m) * rstd * lg[j >> 2][j & 3] + lb4[j >> 2][j & 3];
                    u32x4 o0, o1;
                    o0.x = cvt_pk_bf16(o[0], o[1]); o0.y = cvt_pk_bf16(o[2], o[3]); o0.z = cvt_pk_bf16(o[4], o[5]); o0.w = cvt_pk_bf16(o[6], o[7]);
                    o1.x = cvt_pk_bf16(o[8], o[9]); o1.y = cvt_pk_bf16(o[10], o[11]); o1.z = cvt_pk_bf16(o[12], o[13]); o1.w = cvt_pk_bf16(o[14], o[15]);
                    *(u32x4*)vp = o0; *(u32x4*)(vp + 8) = o1;
                }
            }
        } break;
        case 7: {
            {
                pg8::Gemm g{(const bf16_t*)(ws + O_LB), (const bf16_t*)(ws + WM_L), M_TOK, 5120, KL, KL};
                pg8::StaticOrder S; S.init(M_TOK, 5120, gridDim.x, blockIdx.x);
                EpiLora E{(float*)(ws + O_DEC), (bf16_t*)(ws + O_ABF), (bf16_t*)(ws + O_G), p.in[14], p.in[16]};
                pg8::gemm_phase(lds, g, S, E);
            }
            __syncthreads();
            {
                bf16_t* vnT = (bf16_t*)shm;
                bf16_t* wsb = (bf16_t*)(shm + 34816);
                bf16_t* UV = (bf16_t*)(ws + O_UV);
                const int fr = lane & 15, fq = lane >> 4;
                for (int item = blockIdx.x; item < 96 * 8; item += gridDim.x) {
                    const int n = item >> 3, gi = item & 7;
#pragma unroll
                    for (int i = 0; i < 4; ++i) {
                        const int ch = tid + i * 512, q = ch >> 4, cc = (ch & 15) * 8;
                        const u32x4 w = *(const u32x4*)(UV + (size_t)(n * 128 + q) * 2048 + 1024 + gi * 128 + cc);
                        vnT[(cc + 0) * 136 + q] = (bf16_t)(w.x & 0xffff); vnT[(cc + 1) * 136 + q] = (bf16_t)(w.x >> 16);
                        vnT[(cc + 2) * 136 + q] = (bf16_t)(w.y & 0xffff); vnT[(cc + 3) * 136 + q] = (bf16_t)(w.y >> 16);
                        vnT[(cc + 4) * 136 + q] = (bf16_t)(w.z & 0xffff); vnT[(cc + 5) * 136 + q] = (bf16_t)(w.z >> 16);
                        vnT[(cc + 6) * 136 + q] = (bf16_t)(w.w & 0xffff); vnT[(cc + 7) * 136 + q] = (bf16_t)(w.w >> 16);
                    }
#pragma unroll
                    for (int i = 0; i < 4; ++i) {
                        const int ch = tid + i * 512, pp = ch >> 4, qq = (ch & 15) * 8;
                        const float* sp = p.in[26] + ((size_t)gi * 128 + pp) * 128 + qq;
                        const f32x4 a = ld4(sp), b = ld4(sp + 4);
                        u32x4 w; w.x = cvt_pk_bf16(a[0], a[1]); w.y = cvt_pk_bf16(a[2], a[3]); w.z = cvt_pk_bf16(b[0], b[1]); w.w = cvt_pk_bf16(b[2], b[3]);
                        *(u32x4*)(wsb + pp * 136 + qq) = w;
                    }
                    __syncthreads();
                    f32x4 acc[8];
#pragma unroll
                    for (int pi = 0; pi < 8; ++pi) acc[pi] = (f32x4){0.f, 0.f, 0.f, 0.f};
#pragma unroll
                    for (int ks = 0; ks < 4; ++ks) {
                        const bf16x8 xf = *(const bf16x8*)(vnT + (wid * 16 + fr) * 136 + ks * 32 + fq * 8);
#pragma unroll
                        for (int pi = 0; pi < 8; ++pi) {
                            const bf16x8 yf = *(const bf16x8*)(wsb + (pi * 16 + fr) * 136 + ks * 32 + fq * 8);
                            acc[pi] = __builtin_amdgcn_mfma_f32_16x16x32_bf16(xf, yf, acc[pi], 0, 0, 0);
                        }
                    }
                    u32x2 uwv[8]; float bsv[8];
#pragma unroll
                    for (int pi = 0; pi < 8; ++pi) {
                        const int pp = pi * 16 + fr;
                        bsv[pi] = p.in[27][gi * 128 + pp];
                        uwv[pi] = *(const u32x2*)(UV + (size_t)(n * 128 + pp) * 2048 + gi * 128 + wid * 16 + fq * 4);
                    }
#pragma unroll
                    for (int pi = 0; pi < 8; ++pi) {
                        const int pp = pi * 16 + fr;
                        const float bs = bsv[pi];
                        bf16_t* up = UV + (size_t)(n * 128 + pp) * 2048 + gi * 128 + wid * 16 + fq * 4;
                        const u32x2 uw = uwv[pi];
                        u32x2 o; o.x = cvt_pk_bf16(bflo(uw.x) * (acc[pi][0] + bs), bfhi(uw.x) * (acc[pi][1] + bs));
                        o.y = cvt_pk_bf16(bflo(uw.y) * (acc[pi][2] + bs), bfhi(uw.y) * (acc[pi][3] + bs));
                        *(u32x2*)up = o;
                    }
                    __syncthreads();
                }
            }
        } break;
        case 8: {
            if (wid < 4) {
                __builtin_amdgcn_s_setprio(3);
                LAS unsigned char* wl = lds + wid * (3 * 5696);
                for (int li = blockIdx.x * 4 + wid; li < 1024; li += gridDim.x * 4) {
                    const int d = li & 1, rb = (li >> 1) & 15, h = (li >> 5) & 15, sq = li >> 9;
                    const float* S0 = (d ? p.in[4] : p.in[3]) + (size_t)(sq * 16 + h) * 4096;
                    scan_run<1, 16, 3, true>(ws, p.in[20], wl, lds + 121600 + wid * 512, M_CTX + sq * 2048, 2048, h, d, rb * 4, S0, nullptr, lane);
                }
                __builtin_amdgcn_s_setprio(0);
            } else {
                LAS unsigned char* wl = lds + 4 * (3 * 5696) + (wid - 4) * (2 * 6656);
                for (int ci = blockIdx.x * 4 + (wid - 4); ci < 1024; ci += gridDim.x * 4) {
                    const int d = ci & 1, h = (ci >> 1) & 15, sq = ci >> 5;
                    float* So = p.out + (d ? OUT_SB : OUT_SF) + (size_t)(sq * 16 + h) * 4096;
                    scan_run<4, 4, 2, false>(ws, p.in[20], wl, lds + 121600 + wid * 512, sq * 256, 256, h, d, 0, nullptr, So, lane);
                }
            }
        } break;
        case 9: {
            const bf16_t* Y = (const bf16_t*)(ws + O_Y); const float* R = (const float*)(ws + O_R); const float* Kq = (const float*)(ws + O_K); const float* V = (const float*)(ws + O_V);
            const bf16_t* AB = (const bf16_t*)(ws + O_ABF); bf16_t* G = (bf16_t*)(ws + O_G);

            const int c0 = lane * 16;
            f32x4 kac[4], rkc[4], gngc[4], gnbc[4];
#pragma unroll
            for (int q = 0; q < 4; ++q) { kac[q] = ld4(p.in[20] + c0 + q * 4); rkc[q] = ld4(p.in[21] + c0 + q * 4); gngc[q] = ld4(p.in[22] + c0 + q * 4); gnbc[q] = ld4(p.in[23] + c0 + q * 4); }
            for (int row = blockIdx.x * 8 + wid; row < M_TOK; row += gridDim.x * 8) {
                float y[16], kx[16], rx[16];
                float s = 0.f;
#pragma unroll
                for (int hh = 0; hh < 2; ++hh) {
                    const u32x4 ya = *(const u32x4*)(Y + (size_t)row * 1024 + c0 + hh * 8), yb = *(const u32x4*)(Y + ((size_t)M_TOK + row) * 1024 + c0 + hh * 8);
                    y[hh * 8 + 0] = bflo(ya.x) + bflo(yb.x); y[hh * 8 + 1] = bfhi(ya.x) + bfhi(yb.x); y[hh * 8 + 2] = bflo(ya.y) + bflo(yb.y); y[hh * 8 + 3] = bfhi(ya.y) + bfhi(yb.y);
                    y[hh * 8 + 4] = bflo(ya.z) + bflo(yb.z); y[hh * 8 + 5] = bfhi(ya.z) + bfhi(yb.z); y[hh * 8 + 6] = bflo(ya.w) + bflo(yb.w); y[hh * 8 + 7] = bfhi(ya.w) + bfhi(yb.w);
                }
#pragma unroll
                for (int j = 0; j < 16; ++j) s += y[j];
                s += __shfl_xor(s, 1); s += __shfl_xor(s, 2);
                const float m = s * (1.0f / 64.f);
                float qq = 0.f;
#pragma unroll
                for (int j = 0; j < 16; ++j) { const float dd = y[j] - m; qq += dd * dd; }
                qq += __shfl_xor(qq, 1); qq += __shfl_xor(qq, 2);
                const float rstd = rsqrtf(qq * (1.0f / 64.f) + GN_EPS);
#pragma unroll
                for (int q = 0; q < 4; ++q) {
                    const f32x4 t = ld4(Kq + (size_t)row * 1024 + c0 + q * 4), u = ld4(R + (size_t)row * 1024 + c0 + q * 4);
                    kx[q * 4] = t[0]; kx[q * 4 + 1] = t[1]; kx[q * 4 + 2] = t[2]; kx[q * 4 + 3] = t[3];
                    rx[q * 4] = u[0]; rx[q * 4 + 1] = u[1]; rx[q * 4 + 2] = u[2]; rx[q * 4 + 3] = u[3];
                }
                float coef = 0.f;
#pragma unroll
                for (int d = 0; d < 2; ++d) {
                    const bf16_t* ap = AB + ((size_t)d * M_TOK + row) * 1024 + c0;
                    const u32x4 w0 = *(const u32x4*)ap, w1 = *(const u32x4*)(ap + 8);
                    const float av[16] = {bflo(w0.x), bfhi(w0.x), bflo(w0.y), bfhi(w0.y), bflo(w0.z), bfhi(w0.z), bflo(w0.w), bfhi(w0.w),
                                          bflo(w1.x), bfhi(w1.x), bflo(w1.y), bfhi(w1.y), bflo(w1.z), bfhi(w1.z), bflo(w1.w), bfhi(w1.w)};
#pragma unroll
                    for (int j = 0; j < 16; ++j) {
                        const float ka = kac[j >> 2][j & 3];
                        coef += rx[j] * kx[j] * (1.0f + (av[j] - 1.0f) * ka) * rkc[j >> 2][j & 3];
                    }
                }
                coef += __shfl_xor(coef, 1); coef += __shfl_xor(coef, 2);
                bf16_t* gp = G + (size_t)row * 1024 + c0;
                const u32x4 g0 = *(const u32x4*)gp, g1 = *(const u32x4*)(gp + 8);
                const float gv[16] = {bflo(g0.x), bfhi(g0.x), bflo(g0.y), bfhi(g0.y), bflo(g0.z), bfhi(g0.z), bflo(g0.w), bfhi(g0.w),
                                      bflo(g1.x), bfhi(g1.x), bflo(g1.y), bfhi(g1.y), bflo(g1.z), bfhi(g1.z), bflo(g1.w), bfhi(g1.w)};
                float o[16];
#pragma unroll
                for (int q = 0; q < 4; ++q) {
                    const f32x4 vv = ld4(V + (size_t)row * 1024 + c0 + q * 4);
#pragma unroll
                    for (int j = 0; j < 4; ++j) {
                        const int jj = q * 4 + j;
                        const float yn = (y[jj] - m) * rstd * gngc[q][j] + gnbc[q][j];
                        o[jj] = (yn + coef * vv[j]) * gv[jj];
                    }
                }
                u32x4 o0, o1;
                o0.x = cvt_pk_bf16(o[0], o[1]); o0.y = cvt_pk_bf16(o[2], o[3]); o0.z = cvt_pk_bf16(o[4], o[5]); o0.w = cvt_pk_bf16(o[6], o[7]);
                o1.x = cvt_pk_bf16(o[8], o[9]); o1.y = cvt_pk_bf16(o[10], o[11]); o1.z = cvt_pk_bf16(o[12], o[13]); o1.w = cvt_pk_bf16(o[14], o[15]);
                *(u32x4*)gp = o0; *(u32x4*)(gp + 8) = o1;
            }
        } break;
        case 10: {
            pg8::Gemm g{(const bf16_t*)(ws + O_ABUF), (const bf16_t*)(ws + WM_IN) + (size_t)5632 * DM, M_TOK, 4096, DM, DM};
            pg8::StaticOrder S; S.init(M_TOK, 4096, gridDim.x, blockIdx.x);
            EpiGates E{(bf16_t*)(ws + O_GTS)};
            pg8::gemm_phase(lds, g, S, E);
        } break;
        case 11: {
            pg8::StaticOrder S; S.init(M_TOK, DM, gridDim.x, blockIdx.x);
            {
                pg8::Gemm g{(const bf16_t*)(ws + O_G), (const bf16_t*)(ws + WM_PA), M_TOK, DM, DA, DA};
                EpiMerge<0> E{(const bf16_t*)(ws + O_GTS), (float*)(ws + O_M1), (bf16_t*)(ws + O_ABUF)};
                pg8::gemm_phase(lds, g, S, E);
            }
            {
                pg8::Gemm g{(const bf16_t*)(ws + O_UV), (const bf16_t*)(ws + WM_PB), M_TOK, DM, DA, 2048};
                EpiMerge<1> E{(const bf16_t*)(ws + O_GTS), (float*)(ws + O_M1), (bf16_t*)(ws + O_ABUF)};
                pg8::gemm_phase(lds, g, S, E);
            }
            {
                int i0 = 384 - (int)gridDim.x; if (i0 < 0 || i0 >= (int)gridDim.x) i0 = 0;
                if ((int)blockIdx.x >= i0) { __syncthreads(); conv_T<1>(p.in[10] + (size_t)DM * 2 * DFF, DM, 2 * DFF, (bf16_t*)(ws + WF2_IN), shm, i0, gridDim.x - i0); }
            }
        } break;
        default: break;
        }
    }
}

__global__ void __launch_bounds__(512) mega(Params p, int ph_lo, int ph_hi) {
    cg::grid_group grid = cg::this_grid();
    volatile LAS unsigned* xst = (volatile LAS unsigned*)((LAS unsigned char*)shm + LDS_XB);
    if (threadIdx.x == 0) { xst[0] = 0u; xst[1] = 0u; }
    __syncthreads();
    const XcdBarrier xb = xcd_barrier_post((unsigned*)(p.ws + O_BAR), xst);
    if (ph_lo > ph_hi) grid.sync();
#define RUNPH(n) if (ph_lo <= (n) && (n) < ph_hi) { if ((n) > ph_lo) xcd_barrier(xb); run_phase<n>(p); }
    RUNPH(0) RUNPH(1) RUNPH(2) RUNPH(3) RUNPH(4) RUNPH(5) RUNPH(6) RUNPH(7) RUNPH(8) RUNPH(9) if (ph_lo <= 10 && 10 < ph_hi) run_phase<10>(p);      RUNPH(11) RUNPH(12) RUNPH(13) RUNPH(14) RUNPH(15) RUNPH(16)
#undef RUNPH
}


#ifdef DBG_STOP
__global__ void dbg_copy(const float* src, size_t nsrc, float* out, size_t nout) {
    for (size_t i = (size_t)blockIdx.x * blockDim.x + threadIdx.x; i < nout; i += (size_t)gridDim.x * blockDim.x) out[i] = 0.f;
}
__global__ void dbg_stat(const unsigned short* src, size_t n, float* out, unsigned* cnt) {
    unsigned local = 0;
    for (size_t i = (size_t)blockIdx.x * blockDim.x + threadIdx.x; i < n; i += (size_t)gridDim.x * blockDim.x) {
        const float v = __uint_as_float(((unsigned)src[i]) << 16);
        if (!(fabsf(v) <= DBG_THR)) ++local;
    }
    if (local) atomicAdd(cnt, local);
}
__global__ void dbg_fin(float* out, const unsigned* cnt, double n) { out[0] = cnt[0] ? 100.0f + 100000.0f * (float)((double)cnt[0] / n) : 0.f; }
#endif

extern "C" void kernel_launch(void* const* d_in, const int* in_sizes, int n_in, void* d_out, int out_size, void* d_ws, size_t ws_size, hipStream_t stream) {
    static int grid_blocks = 0;
    if (!grid_blocks) {
        hipFuncSetAttribute((const void*)mega, hipFuncAttributeMaxDynamicSharedMemorySize, LDS_BYTES);
        int dev = 0, cus = 0, per_cu = 0;
        hipGetDevice(&dev);
        hipDeviceGetAttribute(&cus, hipDeviceAttributeMultiprocessorCount, dev);
        hipOccupancyMaxActiveBlocksPerMultiprocessor(&per_cu, mega, 512, LDS_BYTES);
        if (per_cu > 1) per_cu = 1;
        grid_blocks = cus * per_cu;
        if (grid_blocks <= 0) grid_blocks = 256;
    }
    if (ws_size < WS_NEED) { fprintf(stderr, "workspace too small: %zu < %zu\n", ws_size, (size_t)WS_NEED); return; }
    Params p{};
    for (int i = 0; i < 31; ++i) p.in[i] = (const float*)d_in[i];
    p.out = (float*)d_out; p.ws = (unsigned char*)d_ws;
#if COOP
    hipMemsetAsync((unsigned char*)d_ws + O_BAR, 0, XCD_BAR_WORDS * 4, stream);
    int lo = 0, hi = NPH;
    void* args[] = {&p, &lo, &hi};
    hipError_t e = hipLaunchCooperativeKernel((const void*)mega, dim3(grid_blocks), dim3(512), args, LDS_BYTES, stream);
    if (e != hipSuccess) fprintf(stderr, "cooperative launch failed: %s (grid %d)\n", hipGetErrorString(e), grid_blocks);
#else
#ifdef DBG_STOP
    for (int ph = 0; ph <= DBG_STOP; ++ph) mega<<<grid_blocks, 512, LDS_BYTES, stream>>>(p, ph, ph + 1);
    dbg_copy<<<2048, 256, 0, stream>>>((const float*)((unsigned char*)d_ws + DBG_OFF), (size_t)DBG_N, (float*)d_out, (size_t)out_size);
    unsigned* cnt = (unsigned*)((unsigned char*)d_ws + O_MOD + 250000);
    hipMemsetAsync(cnt, 0, 8, stream);
    dbg_stat<<<2048, 256, 0, stream>>>((const unsigned short*)((unsigned char*)d_ws + DBG_SOFF), (size_t)DBG_SN, (float*)d_out, cnt);
    dbg_fin<<<1, 1, 0, stream>>>((float*)d_out, cnt, (double)DBG_SN);
#else
    for (int ph = 0; ph < NPH; ++ph) mega<<<grid_blocks, 512, LDS_BYTES, stream>>>(p, ph, ph + 1);
#endif
#endif
}
```

```cpp
#include <hip/hip_runtime.h>
#include <hip/hip_cooperative_groups.h>
#include <cstdio>
#include <cstdint>
namespace cg = cooperative_groups;

#ifndef COOP
#define COOP 1
#endif

#define LAS __attribute__((address_space(3)))
typedef unsigned short bf16_t;
typedef short bf16x8 __attribute__((ext_vector_type(8)));
typedef float f32x4 __attribute__((ext_vector_type(4)));
typedef float f32x2 __attribute__((ext_vector_type(2)));
typedef unsigned u32x4 __attribute__((ext_vector_type(4)));
typedef unsigned u32x2 __attribute__((ext_vector_type(2)));

constexpr int M_TOK = 12288, M_CTX = 8192, DM = 2048, DFF = 5504, DA = 1024, NZS = 3360, KL = 384, NMOD = 18432;
constexpr float ALPHA = 1.189207115f, LN_EPS = 1e-5f, GN_EPS = 64e-5f;
constexpr int NPH = 17;
constexpr int LDS_BYTES = 147456;

constexpr size_t O_MOD = 0, O_XRES = 262144, O_W = O_XRES + 100663296ull, O_T = O_W + 67633152ull;
constexpr size_t WF_IN = O_W, WF_OUT = O_W + 45088768ull;
constexpr size_t WM_IN = O_W, WM_PA = O_W + 39845888ull, WM_PB = WM_PA + 4194304ull, WM_O = WM_PB + 4194304ull, WM_L = WM_O + 8388608ull;
constexpr size_t O_ABUF = O_T, O_HID = O_T + 50331648ull, O_PRE = O_T + 185597952ull;
constexpr size_t O_ZS = O_T + 50331648ull, O_DEC = O_ZS, O_Y = O_ZS + 100663296ull, O_GTS = O_ZS;
constexpr size_t O_UV = O_T + 215482368ull;
constexpr size_t O_R = O_T + 265814016ull, O_K = O_R + 50331648ull, O_V = O_K + 50331648ull, O_KK = O_V + 50331648ull, O_M1 = O_R;
constexpr size_t O_ABF = O_T + 467140608ull, O_G = O_T + 517472256ull, O_LB = O_T + 542638080ull;
constexpr size_t O_PREB = O_PRE + 100663296ull + 4194304ull;
constexpr size_t WF2_IN = O_KK, WF2_OUT = O_KK + 45088768ull;
constexpr size_t WS_NEED = O_LB + 9437184ull;
constexpr size_t OUT_SF = 25165824ull, OUT_SB = OUT_SF + 2097152ull;

struct Params { const float* in[31]; float* out; unsigned char* ws; };

__device__ __forceinline__ f32x4 ld4(const float* p) { return *(const f32x4*)p; }
__device__ __forceinline__ void st4(float* p, f32x4 v) { *(f32x4*)p = v; }
typedef __bf16 bf16x2_t __attribute__((ext_vector_type(2)));
__device__ __forceinline__ unsigned cvt_pk_bf16(float lo, float hi) { bf16x2_t v = {(__bf16)lo, (__bf16)hi}; return __builtin_bit_cast(unsigned, v); }
__device__ __forceinline__ float bflo(unsigned u) { return __uint_as_float(u << 16); }
__device__ __forceinline__ float bfhi(unsigned u) { return __uint_as_float(u & 0xffff0000u); }
__device__ __forceinline__ f32x4 ldbf4(const bf16_t* p) { const u32x2 w = *(const u32x2*)p; return (f32x4){bflo(w.x), bfhi(w.x), bflo(w.y), bfhi(w.y)}; }
__device__ __forceinline__ void stbf8(bf16_t* p, f32x4 v0, f32x4 v1) { u32x4 w; w.x = cvt_pk_bf16(v0[0], v0[1]); w.y = cvt_pk_bf16(v0[2], v0[3]); w.z = cvt_pk_bf16(v1[0], v1[1]); w.w = cvt_pk_bf16(v1[2], v1[3]); *(u32x4*)p = w; }
__device__ __forceinline__ void unpack8(const u32x4 w, f32x4& lo, f32x4& hi) { lo = (f32x4){bflo(w.x), bfhi(w.x), bflo(w.y), bfhi(w.y)}; hi = (f32x4){bflo(w.z), bfhi(w.z), bflo(w.w), bfhi(w.w)}; }
__device__ __forceinline__ void shift16(const bf16_t* z, const bf16_t* z0, const bf16_t* z1, const bf16_t* z2, const bf16_t* z3, const float* mu, int cb, bool lat,
                                        float f0, float f1, float f2, float f3, float wgt, f32x4 (&out)[4]) {
    const u32x4 zA = *(const u32x4*)(z + cb), zB = *(const u32x4*)(z + cb + 8);
    const u32x4 aA = *(const u32x4*)(z0 + cb), aB = *(const u32x4*)(z0 + cb + 8);
    const u32x4 bA = *(const u32x4*)(z1 + cb), bB = *(const u32x4*)(z1 + cb + 8);
    u32x4 cA = zA, cB = zB, dA = zA, dB = zB;
    if (lat) { cA = *(const u32x4*)(z2 + cb); cB = *(const u32x4*)(z2 + cb + 8); dA = *(const u32x4*)(z3 + cb); dB = *(const u32x4*)(z3 + cb + 8); }
    f32x4 zz[4], n0[4], n1[4];
    unpack8(zA, zz[0], zz[1]); unpack8(zB, zz[2], zz[3]);
    unpack8(aA, n0[0], n0[1]); unpack8(aB, n0[2], n0[3]);
    unpack8(bA, n1[0], n1[1]); unpack8(bB, n1[2], n1[3]);
#pragma unroll
    for (int q = 0; q < 4; ++q) n0[q] = n0[q] * f0 + n1[q] * f1;
    if (lat) {
        f32x4 n2[4], n3[4];
        unpack8(cA, n2[0], n2[1]); unpack8(cB, n2[2], n2[3]);
        unpack8(dA, n3[0], n3[1]); unpack8(dB, n3[2], n3[3]);
#pragma unroll
        for (int q = 0; q < 4; ++q) n0[q] += n2[q] * f2 + n3[q] * f3;
    }
#pragma unroll
    for (int q = 0; q < 4; ++q) out[q] = zz[q] + ld4(mu + cb + q * 4) * (n0[q] * wgt - zz[q]);
}
__device__ __forceinline__ float sigmoidf_(float x) { return __builtin_amdgcn_rcpf(1.0f + __expf(-x)); }
__device__ __forceinline__ float wsum(float x) {
#pragma unroll
    for (int o = 32; o > 0; o >>= 1) x += __shfl_xor(x, o);
    return x;
}
__device__ __forceinline__ f32x2 gelu_pk(f32x2 v) {
    const f32x2 av = __builtin_elementwise_abs(v), d = av * 0.2316418882f + 1.0f;
    f32x2 t; t.x = __builtin_amdgcn_rcpf(d.x); t.y = __builtin_amdgcn_rcpf(d.y);
    f32x2 q = t * 0.5307027145f + (-0.7265760135f); q = q * t + 0.7107068705f; q = q * t + (-0.142248368f); q = q * t + 0.127414796f; q = q * t;
    const f32x2 s = (v * v) * (-0.72134752044f);
    f32x2 e; e.x = __builtin_amdgcn_exp2f(s.x); e.y = __builtin_amdgcn_exp2f(s.y);
    const f32x2 m = v * (q * e), r = v - m;
    f32x2 o; o.x = v.x < 0.f ? m.x : r.x; o.y = v.y < 0.f ? m.y : r.y; return o;
}
__device__ __forceinline__ int cond_of_row(int row) { return row < M_CTX ? 0 : 1 + ((row - M_CTX) >> 11); }

namespace pg8 {
constexpr int BM = 256, BK = 64, HALF = 128, HTB = HALF * BK * 2, STAGE_BYTES = 8 * HTB, NXCD = 8, WGM = 8;
__device__ __forceinline__ int lds_byte(int r, int c) { const int st = (r >> 4) * 2 + (c >> 5), rr = r & 15, cc = c & 31, ob = rr * 64 + cc * 2; return st * 1024 + (ob ^ (((ob >> 9) & 1) << 5)); }
__device__ __forceinline__ void stage_rc(int b, int& R, int& C) { const int st = b / 1024, sb = b % 1024, swz = sb ^ (((sb >> 9) & 1) << 5); R = (st >> 1) * 16 + swz / 64; C = (st & 1) * 32 + (swz % 64) / 2; }
__device__ __forceinline__ int perm32(int rho) { const int n = rho >> 4, i = rho & 15; return 8 * (i >> 2) + 4 * n + (i & 3); }
struct Unit { int pm, pn; };
struct Gemm { const bf16_t* A; const bf16_t* Bt; int M, N, K, lda, ldb; };
struct StaticOrder {
    int nM, nN, nwg, G, c;
    __device__ void init(int M, int N, int G_, int c_) { nM = M / BM; nN = N / BM; nwg = nM * nN; G = G_; c = c_; }
    __device__ bool next(int i, Unit& u) const {
        const long L = (long)i * G + c; if (L >= nwg) return false;
        int wgid = (int)L; { const int q = nwg / NXCD, r = nwg % NXCD, xcd = wgid % NXCD, off = wgid / NXCD; wgid = (xcd < r ? xcd * (q + 1) : r * (q + 1) + (xcd - r) * q) + off; }
        const int nig = WGM * nN, gid = wgid / nig, fm = gid * WGM, gsz = (nM - fm) < WGM ? (nM - fm) : WGM;
        u.pm = fm + ((wgid % nig) % gsz); u.pn = (wgid % nig) / gsz; return true;
    }
};
template <class Epi>
__device__ __forceinline__ void gemm_phase(LAS unsigned char* lds, const Gemm g, const StaticOrder& S, const Epi& E) {
    const int tid = threadIdx.x, wid = __builtin_amdgcn_readfirstlane(tid >> 6), lane = tid & 63, wr = wid >> 2, wc = wid & 3, fr = lane & 15, fq = lane >> 4;
    const int K = g.K, nt = K / BK, lda = g.lda, ldb = g.ldb ? g.ldb : g.K;
    unsigned voffA[2], voffB[2];
#pragma unroll
    for (int i = 0; i < 2; ++i) { int R, C; stage_rc(tid * 16 + i * 8192, R, C); const int Rb = (R & ~31) + perm32(R & 31);
        voffA[i] = (unsigned)(R * lda + C) * 2u; voffB[i] = (unsigned)(Rb * ldb + C) * 2u; }
    const size_t kstep = (size_t)(BK * 2);
    const size_t hstepA = (size_t)HALF * lda * 2, hstepB = (size_t)HALF * ldb * 2;
    const size_t tstepA = 2 * hstepA, tstepB = 2 * hstepB;
    const unsigned ldsw = (unsigned)wid * 1024u;
    const int aoff = lds_byte(wr * 64 + fr, fq * 8), boff = lds_byte(wc * 32 + fr, fq * 8);
#define PG8_SA(b, h) (((b) * 2 + (h)) * HTB)
#define PG8_SB(b, h) ((4 + (b) * 2 + (h)) * HTB)
#define PG8_STAGE(bufoff, gbase, voff) do { _Pragma("unroll") for (int _i = 0; _i < 2; ++_i) \
        __builtin_amdgcn_global_load_lds((const unsigned*)((const char*)(gbase) + (voff)[_i]), (LAS unsigned*)(lds + (bufoff) + ldsw + _i * 8192), 16, 0, 0); } while (0)
#define PG8_LDA(dst, b, h) do { _Pragma("unroll") for (int m = 0; m < 4; ++m) _Pragma("unroll") for (int k = 0; k < 2; ++k) dst[m][k] = *(const LAS bf16x8*)(lds + PG8_SA(b, h) + aoff + m * 2048 + k * 1024); } while (0)
#define PG8_LDB(dst, b, h) do { _Pragma("unroll") for (int n = 0; n < 2; ++n) _Pragma("unroll") for (int k = 0; k < 2; ++k) dst[n][k] = *(const LAS bf16x8*)(lds + PG8_SB(b, h) + boff + n * 2048 + k * 1024); } while (0)
#define PG8_MMA(ai, bj, At, Bt) do { __builtin_amdgcn_s_setprio(1); _Pragma("unroll") for (int m = 0; m < 4; ++m) _Pragma("unroll") for (int n = 0; n < 2; ++n) _Pragma("unroll") for (int k = 0; k < 2; ++k) \
        acc[ai][bj][m][n] = __builtin_amdgcn_mfma_f32_16x16x32_bf16(Bt[n][k], At[m][k], acc[ai][bj][m][n], 0, 0, 0); __builtin_amdgcn_s_setprio(0); } while (0)
#define PG8_WAIT_V(n) asm volatile("s_waitcnt vmcnt(" #n ")" ::: "memory")
#define PG8_WAIT_L(n) asm volatile("s_waitcnt lgkmcnt(" #n ")" ::: "memory")
#define PG8_BAR __builtin_amdgcn_s_barrier()
#define PG8_SCHED __builtin_amdgcn_sched_barrier(0)
    Unit cur, nxt; int ui = 0;
    if (!S.next(0, cur)) return;
    f32x4 acc[2][2][4][2];
#pragma unroll
    for (int a = 0; a < 2; ++a)
#pragma unroll
        for (int b = 0; b < 2; ++b)
#pragma unroll
            for (int m = 0; m < 4; ++m)
#pragma unroll
                for (int n = 0; n < 2; ++n) acc[a][b][m][n] = (f32x4){0.f, 0.f, 0.f, 0.f};
    bf16x8 At[4][2], B0[2][2], B1[2][2];
    const char* cA = (const char*)g.A + (size_t)cur.pm * tstepA; const char* cB = (const char*)g.Bt + (size_t)cur.pn * tstepB;
    PG8_STAGE(PG8_SB(0, 0), cB, voffB); PG8_STAGE(PG8_SA(0, 0), cA, voffA); PG8_STAGE(PG8_SB(0, 1), cB + hstepB, voffB); PG8_STAGE(PG8_SA(0, 1), cA + hstepA, voffA);
    if (wr == 1) PG8_BAR;
    PG8_WAIT_V(4); PG8_BAR;
    PG8_STAGE(PG8_SB(1, 0), cB + kstep, voffB); PG8_STAGE(PG8_SA(1, 0), cA + kstep, voffA); PG8_STAGE(PG8_SB(1, 1), cB + hstepB + kstep, voffB);
    PG8_WAIT_V(6); PG8_BAR;
    for (;;) {
        const bool has_next = S.next(ui + 1, nxt);
        const char* nA = has_next ? (const char*)g.A + (size_t)nxt.pm * tstepA : cA; const char* nB = has_next ? (const char*)g.Bt + (size_t)nxt.pn * tstepB : cB;
        for (int t = 0; t < nt; t += 2) {
            const bool last = (t == nt - 2);
            const char* a1 = cA + (size_t)(t + 1) * kstep;
            const char* a2 = last ? nA : cA + (size_t)(t + 2) * kstep; const char* b2 = last ? nB : cB + (size_t)(t + 2) * kstep;
            const char* a3 = a2 + kstep; const char* b3 = b2 + kstep;
            PG8_LDB(B0, 0, 0); PG8_SCHED; PG8_LDA(At, 0, 0); PG8_STAGE(PG8_SA(1, 1), a1 + hstepA, voffA);
            PG8_WAIT_L(8); PG8_BAR; PG8_WAIT_L(0); PG8_MMA(0, 0, At, B0); PG8_BAR; PG8_SCHED;
            PG8_LDB(B1, 0, 1); PG8_STAGE(PG8_SB(0, 0), b2, voffB);
            PG8_BAR; PG8_WAIT_L(0); PG8_MMA(0, 1, At, B1); PG8_BAR;
            PG8_LDA(At, 0, 1); PG8_STAGE(PG8_SA(0, 0), a2, voffA);
            PG8_BAR; PG8_WAIT_L(0); PG8_MMA(1, 0, At, B0); PG8_BAR; PG8_SCHED;
            PG8_STAGE(PG8_SB(0, 1), b2 + hstepB, voffB);
            PG8_WAIT_V(6); PG8_BAR; PG8_MMA(1, 1, At, B1); PG8_BAR;
            PG8_LDB(B0, 1, 0); PG8_SCHED; PG8_LDA(At, 1, 0); PG8_STAGE(PG8_SA(0, 1), a2 + hstepA, voffA);
            PG8_WAIT_L(8); PG8_BAR; PG8_WAIT_L(0); PG8_MMA(0, 0, At, B0); PG8_BAR; PG8_SCHED;
            PG8_LDB(B1, 1, 1); PG8_STAGE(PG8_SB(1, 0), b3, voffB);
            PG8_BAR; PG8_WAIT_L(0); PG8_MMA(0, 1, At, B1); PG8_BAR;
            PG8_LDA(At, 1, 1); PG8_STAGE(PG8_SA(1, 0), a3, voffA);
            PG8_BAR; PG8_WAIT_L(0); PG8_MMA(1, 0, At, B0); PG8_BAR; PG8_SCHED;
            PG8_STAGE(PG8_SB(1, 1), b3 + hstepB, voffB);
            PG8_WAIT_V(6); PG8_BAR; PG8_MMA(1, 1, At, B1); PG8_BAR;
        }
        E(acc, cur, wr, wc, fr, fq);
        if (!has_next) break;
#pragma unroll
        for (int a = 0; a < 2; ++a)
#pragma unroll
            for (int b = 0; b < 2; ++b)
#pragma unroll
                for (int m = 0; m < 4; ++m)
#pragma unroll
                    for (int n = 0; n < 2; ++n) acc[a][b][m][n] = (f32x4){0.f, 0.f, 0.f, 0.f};
        cur = nxt; cA = nA; cB = nB; ++ui;
    }
    PG8_WAIT_V(0);
    if (wr == 0) PG8_BAR;
    PG8_BAR;
#undef PG8_SA
#undef PG8_SB
#undef PG8_STAGE
#undef PG8_LDA
#undef PG8_LDB
#undef PG8_MMA
#undef PG8_WAIT_V
#undef PG8_WAIT_L
#undef PG8_BAR
#undef PG8_SCHED
}
}
using pg8::Unit;
typedef f32x4 Acc[2][2][4][2];

struct EpiSwiglu {
    bf16_t* H;
    __device__ __forceinline__ void operator()(const Acc& acc, const Unit& u, int wr, int wc, int fr, int fq) const {
        const int row0 = u.pm * 256 + wr * 64 + fr, col = u.pn * 128 + wc * 32 + 8 * fq;
#pragma unroll
        for (int ai = 0; ai < 2; ++ai)
#pragma unroll
            for (int m = 0; m < 4; ++m) {
                const int row = row0 + ai * 128 + m * 16;
                float h[8];
#pragma unroll
                for (int n = 0; n < 2; ++n)
#pragma unroll
                    for (int j = 0; j < 4; ++j) { const float a = acc[ai][0][m][n][j], b = acc[ai][1][m][n][j]; h[n * 4 + j] = a * sigmoidf_(a) * b; }
                u32x4 w; w.x = cvt_pk_bf16(h[0], h[1]); w.y = cvt_pk_bf16(h[2], h[3]); w.z = cvt_pk_bf16(h[4], h[5]); w.w = cvt_pk_bf16(h[6], h[7]);
                *(u32x4*)(H + (size_t)row * DFF + col) = w;
            }
    }
};
template <int XB> struct EpiResid {
    const float* xa; const float* xb; const float* mod; int gidx; float gs; bf16_t* out;
    __device__ __forceinline__ void operator()(const Acc& acc, const Unit& u, int wr, int wc, int fr, int fq) const {
        const int row0 = u.pm * 256 + wr * 64 + fr, col0 = u.pn * 256 + wc * 32 + 8 * fq;
        const int ci = u.pm < 32 ? 0 : 1 + ((u.pm - 32) >> 3);
        const float* gate = mod + (size_t)ci * NMOD + gidx * DM;
        const float* xbase = u.pm < 32 ? xa : xb;
#pragma unroll
        for (int bj = 0; bj < 2; ++bj) {
            const int col = col0 + bj * 128;
            const f32x4 g0 = ld4(gate + col) * gs, g1 = ld4(gate + col + 4) * gs;
#pragma unroll
            for (int ai = 0; ai < 2; ++ai) {
                f32x4 x0[4], x1[4];
#pragma unroll
                for (int m = 0; m < 4; ++m) {
                    const size_t o = (size_t)(row0 + ai * 128 + m * 16) * DM + col;
                    if (XB) { const u32x4 xw = *(const u32x4*)((const bf16_t*)xbase + o); x0[m] = (f32x4){bflo(xw.x), bfhi(xw.x), bflo(xw.y), bfhi(xw.y)}; x1[m] = (f32x4){bflo(xw.z), bfhi(xw.z), bflo(xw.w), bfhi(xw.w)}; }
                    else { x0[m] = ld4(xbase + o); x1[m] = ld4(xbase + o + 4); }
                }
                __builtin_amdgcn_sched_barrier(0);
#pragma unroll
                for (int m = 0; m < 4; ++m) {
                    const size_t o = (size_t)(row0 + ai * 128 + m * 16) * DM + col;
                    stbf8(out + o, x0[m] * ALPHA + g0 * acc[ai][bj][m][0], x1[m] * ALPHA + g1 * acc[ai][bj][m][1]);
                }
                __builtin_amdgcn_sched_barrier(0);
            }
        }
    }
};
template <int PART> struct EpiResidSplit {
    const float* x; const float* mod; bf16_t* out;
    __device__ __forceinline__ void operator()(const Acc& acc, const Unit& u, int wr, int wc, int fr, int fq) const {
        const int lrow0 = u.pm * 256 + wr * 64 + fr, col0 = u.pn * 256 + wc * 32 + 8 * fq;
        const float* gate = mod + (size_t)(1 + (u.pm >> 3)) * NMOD + 8 * DM;
#pragma unroll
        for (int bj = 0; bj < 2; ++bj) {
            const int col = col0 + bj * 128;
            const f32x4 g0 = ld4(gate + col) * 0.5f, g1 = ld4(gate + col + 4) * 0.5f;
#pragma unroll
            for (int ai = 0; ai < 2; ++ai) {
                u32x4 xw[4];
                if (PART == 0) {
#pragma unroll
                    for (int m = 0; m < 4; ++m) xw[m] = *(const u32x4*)((const bf16_t*)x + (size_t)(lrow0 + ai * 128 + m * 16 + 8192) * DM + col);
                    __builtin_amdgcn_sched_barrier(0);
                }
#pragma unroll
                for (int m = 0; m < 4; ++m) {
                    const size_t lo = (size_t)(lrow0 + ai * 128 + m * 16) * DM + col;
                    if (PART == 0) {
                        const size_t o = lo + (size_t)8192 * DM;
                        const f32x4 x0 = {bflo(xw[m].x), bfhi(xw[m].x), bflo(xw[m].y), bfhi(xw[m].y)}, x1 = {bflo(xw[m].z), bfhi(xw[m].z), bflo(xw[m].w), bfhi(xw[m].w)};
                        stbf8(out + o, x0 * ALPHA + g0 * acc[ai][bj][m][0], x1 * ALPHA + g1 * acc[ai][bj][m][1]);
                    } else {
                        stbf8(out + lo, g0 * acc[ai][bj][m][0], g1 * acc[ai][bj][m][1]);
                    }
                }
                __builtin_amdgcn_sched_barrier(0);
            }
        }
    }
};
struct EpiProj {
    bf16_t* zs; bf16_t* uv;
    __device__ __forceinline__ void operator()(const Acc& acc, const Unit& u, int wr, int wc, int fr, int fq) const {
        const int row0 = u.pm * 256 + wr * 64 + fr;
        if (u.pn < 14) {
#pragma unroll
            for (int bj = 0; bj < 2; ++bj) {
                const int col = u.pn * 256 + bj * 128 + wc * 32 + 8 * fq;
                if (col < NZS) {
#pragma unroll
                    for (int ai = 0; ai < 2; ++ai)
#pragma unroll
                        for (int m = 0; m < 4; ++m) {
                            const f32x4 v0 = acc[ai][bj][m][0], v1 = acc[ai][bj][m][1];
                            u32x4 w; w.x = cvt_pk_bf16(v0[0], v0[1]); w.y = cvt_pk_bf16(v0[2], v0[3]); w.z = cvt_pk_bf16(v1[0], v1[1]); w.w = cvt_pk_bf16(v1[2], v1[3]);
                            *(u32x4*)(zs + (size_t)(row0 + ai * 128 + m * 16) * NZS + col) = w;
                        }
                }
            }
        } else {
#pragma unroll
            for (int bj = 0; bj < 2; ++bj) {
                const int col = (u.pn - 14) * 256 + bj * 128 + wc * 32 + 8 * fq;
#pragma unroll
                for (int ai = 0; ai < 2; ++ai)
#pragma unroll
                    for (int m = 0; m < 4; ++m) {
                        const f32x4 v0 = acc[ai][bj][m][0], v1 = acc[ai][bj][m][1];
                        const f32x2 a = gelu_pk((f32x2){v0[0], v0[1]}), b = gelu_pk((f32x2){v0[2], v0[3]}), c = gelu_pk((f32x2){v1[0], v1[1]}), d = gelu_pk((f32x2){v1[2], v1[3]});
                        u32x4 w; w.x = cvt_pk_bf16(a.x, a.y); w.y = cvt_pk_bf16(b.x, b.y); w.z = cvt_pk_bf16(c.x, c.y); w.w = cvt_pk_bf16(d.x, d.y);
                        *(u32x4*)(uv + (size_t)(row0 + ai * 128 + m * 16) * 2048 + col) = w;
                    }
            }
        }
    }
};
struct EpiGates {
    bf16_t* gts;
    __device__ __forceinline__ void operator()(const Acc& acc, const Unit& u, int wr, int wc, int fr, int fq) const {
        const int row0 = u.pm * 256 + wr * 64 + fr;
#pragma unroll
        for (int bj = 0; bj < 2; ++bj) {
            const int col = u.pn * 256 + bj * 128 + wc * 32 + 8 * fq;
#pragma unroll
            for (int ai = 0; ai < 2; ++ai)
#pragma unroll
                for (int m = 0; m < 4; ++m) {
                    const f32x4 v0 = acc[ai][bj][m][0], v1 = acc[ai][bj][m][1];
                    u32x4 w; w.x = cvt_pk_bf16(sigmoidf_(v0[0]), sigmoidf_(v0[1])); w.y = cvt_pk_bf16(sigmoidf_(v0[2]), sigmoidf_(v0[3]));
                    w.z = cvt_pk_bf16(sigmoidf_(v1[0]), sigmoidf_(v1[1])); w.w = cvt_pk_bf16(sigmoidf_(v1[2]), sigmoidf_(v1[3]));
                    *(u32x4*)(gts + (size_t)(row0 + ai * 128 + m * 16) * 4096 + col) = w;
                }
        }
    }
};
struct EpiLora {
    float* dec; bf16_t* abf; bf16_t* gg; const float* w0; const float* a0;
    __device__ __forceinline__ void operator()(const Acc& acc, const Unit& u, int wr, int wc, int fr, int fq) const {
        const int row0 = u.pm * 256 + wr * 64 + fr;
        const int sec = u.pn >> 2;
        const float* bias = sec < 2 ? w0 + sec * 1024 : a0 + ((sec - 2) & 1) * 1024;
#pragma unroll
        for (int bj = 0; bj < 2; ++bj) {
            const int col = (u.pn & 3) * 256 + bj * 128 + wc * 32 + 8 * fq;
            f32x4 b0 = {0.f, 0.f, 0.f, 0.f}, b1 = b0;
            if (sec < 4) { b0 = ld4(bias + col); b1 = ld4(bias + col + 4); }
#pragma unroll
            for (int ai = 0; ai < 2; ++ai)
#pragma unroll
                for (int m = 0; m < 4; ++m) {
                    const size_t row = (size_t)(row0 + ai * 128 + m * 16);
                    const f32x4 v0 = acc[ai][bj][m][0] + b0, v1 = acc[ai][bj][m][1] + b1;
                    if (sec < 2) {
                        f32x4 o0, o1;
#pragma unroll
                        for (int j = 0; j < 4; ++j) { o0[j] = __expf(-0.6065306597f * sigmoidf_(v0[j])); o1[j] = __expf(-0.6065306597f * sigmoidf_(v1[j])); }
                        float* p = dec + ((size_t)sec * M_TOK + row) * 1024 + col;
                        st4(p, o0); st4(p + 4, o1);
                    } else {
                        f32x4 o0 = v0, o1 = v1;
                        if (sec < 4) {
#pragma unroll
                            for (int j = 0; j < 4; ++j) { o0[j] = sigmoidf_(v0[j]); o1[j] = sigmoidf_(v1[j]); }
                        }
                        u32x4 w; w.x = cvt_pk_bf16(o0[0], o0[1]); w.y = cvt_pk_bf16(o0[2], o0[3]); w.z = cvt_pk_bf16(o1[0], o1[1]); w.w = cvt_pk_bf16(o1[2], o1[3]);
                        bf16_t* dst = sec < 4 ? abf + ((size_t)(sec - 2) * M_TOK + row) * 1024 + col : gg + row * 1024 + col;
                        *(u32x4*)dst = w;
                    }
                    __builtin_amdgcn_sched_barrier(0);
                }
        }
    }
};
template <int SECOND> struct EpiMerge {
    const bf16_t* gts; float* m1; bf16_t* merged;
    __device__ __forceinline__ void operator()(const Acc& acc, const Unit& u, int wr, int wc, int fr, int fq) const {
        const int row0 = u.pm * 256 + wr * 64 + fr;
#pragma unroll
        for (int bj = 0; bj < 2; ++bj) {
            const int col = u.pn * 256 + bj * 128 + wc * 32 + 8 * fq;
#pragma unroll
            for (int ai = 0; ai < 2; ++ai) {
                u32x4 gw[4], pw[4];
#pragma unroll
                for (int m = 0; m < 4; ++m) {
                    const size_t row = (size_t)(row0 + ai * 128 + m * 16);
                    gw[m] = *(const u32x4*)(gts + row * 4096 + SECOND * 2048 + col);
                    if (SECOND) pw[m] = *(const u32x4*)(merged + row * DM + col);
                }
                __builtin_amdgcn_sched_barrier(0);
#pragma unroll
                for (int m = 0; m < 4; ++m) {
                    const size_t row = (size_t)(row0 + ai * 128 + m * 16);
                    const f32x4 g0 = {bflo(gw[m].x), bfhi(gw[m].x), bflo(gw[m].y), bfhi(gw[m].y)}, g1 = {bflo(gw[m].z), bfhi(gw[m].z), bflo(gw[m].w), bfhi(gw[m].w)};
                    f32x4 v0 = g0 * acc[ai][bj][m][0], v1 = g1 * acc[ai][bj][m][1];
                    if (SECOND) { v0 += (f32x4){bflo(pw[m].x), bfhi(pw[m].x), bflo(pw[m].y), bfhi(pw[m].y)}; v1 += (f32x4){bflo(pw[m].z), bfhi(pw[m].z), bflo(pw[m].w), bfhi(pw[m].w)}; }
                    stbf8(merged + row * DM + col, v0, v1);
                }
                __builtin_amdgcn_sched_barrier(0);
            }
        }
    }
};

template <int MODE> __device__ __forceinline__ int maprow(int n) {
    if (MODE == 1) { const int half = n >= DFF ? 1 : 0; const int i = n - half * DFF; return (i >> 7) * 256 + half * 128 + (i & 127); }
    if (MODE == 2) { return n < NZS ? n : n + 224; }
    return n;
}
template <int MODE> __device__ __forceinline__ void conv_T(const float* src, int K, int N, bf16_t* dst, unsigned char* lds, int b0, int nb) {
    const int tid = threadIdx.x, kg = tid >> 6, nq = tid & 63;
    const int nkt = K / 64, nnt = (N + 255) / 256, ntile = nkt * nnt;
    for (int t = (int)blockIdx.x - b0; t < ntile; t += nb) {
        const int kt = t % nkt, ntl = t / nkt, k0 = kt * 64 + kg * 8, n0 = ntl * 256 + nq * 4;
        f32x4 v[8];
#pragma unroll
        for (int i = 0; i < 8; ++i) { v[i] = (f32x4){0.f, 0.f, 0.f, 0.f}; if (n0 < N) v[i] = ld4(src + (size_t)(k0 + i) * N + n0); }
#pragma unroll
        for (int j = 0; j < 4; ++j) {
            u32x4 w; w.x = cvt_pk_bf16(v[0][j], v[1][j]); w.y = cvt_pk_bf16(v[2][j], v[3][j]); w.z = cvt_pk_bf16(v[4][j], v[5][j]); w.w = cvt_pk_bf16(v[6][j], v[7][j]);
            *(u32x4*)(lds + (nq * 4 + j) * 144 + kg * 16) = w;
        }
        __syncthreads();
        const int n = tid >> 1, kh = tid & 1, gn = ntl * 256 + n;
        if (gn < N) {
            bf16_t* d = dst + (size_t)maprow<MODE>(gn) * K + kt * 64 + kh * 32;
#pragma unroll
            for (int q = 0; q < 4; ++q) *(u32x4*)(d + q * 8) = *(const u32x4*)(lds + n * 144 + kh * 64 + q * 16);
        }
        __syncthreads();
    }
}

template <bool FINAL> __device__ __forceinline__ void ln_rows(const bf16_t* pre, const float* g, const float* b, float* xout, bf16_t* aout, const float* mod, int modi, const bf16_t* preB = nullptr) {
    const int lane = threadIdx.x & 63, gw = blockIdx.x * 8 + (threadIdx.x >> 6), nw = gridDim.x * 8;
    f32x4 gg[8], bb[8], v[8];
#pragma unroll
    for (int i = 0; i < 8; ++i) { gg[i] = ld4(g + i * 256 + lane * 4); bb[i] = ld4(b + i * 256 + lane * 4); v[i] = (f32x4){0.f, 0.f, 0.f, 0.f}; }
    if (gw < M_TOK) {
#pragma unroll
        for (int i = 0; i < 8; ++i) { v[i] = ldbf4(pre + (size_t)gw * DM + i * 256 + lane * 4); if (FINAL) { if (preB && gw >= 8192) v[i] += ldbf4(preB + (size_t)(gw - 8192) * DM + i * 256 + lane * 4); } }
    }
    for (int row = gw; row < M_TOK; row += nw) {
        const int nrow = row + nw;
        f32x4 vn[8], sc[8], sh[8];
#pragma unroll
        for (int i = 0; i < 8; ++i) vn[i] = (f32x4){0.f, 0.f, 0.f, 0.f};
        if (nrow < M_TOK) {
#pragma unroll
            for (int i = 0; i < 8; ++i) { vn[i] = ldbf4(pre + (size_t)nrow * DM + i * 256 + lane * 4); if (FINAL) { if (preB && nrow >= 8192) vn[i] += ldbf4(preB + (size_t)(nrow - 8192) * DM + i * 256 + lane * 4); } }
        }
        if (!FINAL) {
            const float* md = mod + (size_t)cond_of_row(row) * NMOD + (3 * modi) * DM;
#pragma unroll
            for (int i = 0; i < 8; ++i) { sc[i] = ld4(md + DM + i * 256 + lane * 4); sh[i] = ld4(md + i * 256 + lane * 4); }
        }
        float s = 0.f;
#pragma unroll
        for (int i = 0; i < 8; ++i) s += (v[i][0] + v[i][1]) + (v[i][2] + v[i][3]);
        const float mu = wsum(s) * (1.0f / DM);
        float q = 0.f;
#pragma unroll
        for (int i = 0; i < 8; ++i) { const f32x4 d = v[i] - mu; q += (d[0] * d[0] + d[1] * d[1]) + (d[2] * d[2] + d[3] * d[3]); }
        const float rstd = rsqrtf(wsum(q) * (1.0f / DM) + LN_EPS);
#pragma unroll
        for (int i = 0; i < 8; ++i) {
            const int c = i * 256 + lane * 4;
            const f32x4 x = (v[i] - mu) * rstd * gg[i] + bb[i];
            if (FINAL) st4(xout + (size_t)row * DM + c, x);
            else {
                u32x2 xw; xw.x = cvt_pk_bf16(x[0], x[1]); xw.y = cvt_pk_bf16(x[2], x[3]); *(u32x2*)((bf16_t*)xout + (size_t)row * DM + c) = xw;
                const f32x4 a = x * (sc[i] + 1.0f) + sh[i];
                u32x2 w; w.x = cvt_pk_bf16(a[0], a[1]); w.y = cvt_pk_bf16(a[2], a[3]);
                *(u32x2*)(aout + (size_t)row * DM + c) = w;
            }
        }
#pragma unroll
        for (int i = 0; i < 8; ++i) v[i] = vn[i];
    }
}

template <int CTRL> __device__ __forceinline__ float dpp_add(float x) {
    const int y = __builtin_amdgcn_update_dpp(0, __float_as_int(x), CTRL, 0xF, 0xF, true);
    return x + __int_as_float(y);
}
template <int L> __device__ __forceinline__ float redL(float x) {
    x = dpp_add<0xB1>(x); x = dpp_add<0x4E>(x);
    if (L >= 8) x = dpp_add<0x141>(x);
    if (L >= 16) x = dpp_add<0x140>(x);
    return x;
}
template <bool VC> __device__ __forceinline__ void scan_issue(LAS unsigned char* buf, const char* gdec, const char* gkk, const char* gk, const char* gr, const char* gv, const char* ga,
                                                              unsigned offF, unsigned offA, unsigned offV, int lane) {
    __builtin_amdgcn_global_load_lds((const unsigned*)(gdec + offF), (LAS unsigned*)(buf + 0), 16, 0, 0);
    __builtin_amdgcn_global_load_lds((const unsigned*)(gkk + offF), (LAS unsigned*)(buf + 1024), 16, 0, 0);
    __builtin_amdgcn_global_load_lds((const unsigned*)(gk + offF), (LAS unsigned*)(buf + 2048), 16, 0, 0);
    __builtin_amdgcn_global_load_lds((const unsigned*)(gr + offF), (LAS unsigned*)(buf + 3072), 16, 0, 0);
    if (!VC) __builtin_amdgcn_global_load_lds((const unsigned*)(gv + offF), (LAS unsigned*)(buf + 4608), 16, 0, 0);
    if (lane < 32) __builtin_amdgcn_global_load_lds((const unsigned*)(ga + offA), (LAS unsigned*)(buf + 4096), 16, 0, 0);
    if (VC) { if (lane < 4) __builtin_amdgcn_global_load_lds((const unsigned*)(gv + offV), (LAS unsigned*)(buf + 4608), 16, 0, 0); }
}
template <int RR, int L, int NB, bool VC>
__device__ __forceinline__ void scan_run(const unsigned char* ws, const float* rw_k_a, LAS unsigned char* wl, LAS unsigned char* ys, int tok0, int T, int h, int d, int rowbase,
                                         const float* S0, float* Sout, int lane) {
    constexpr int E = 64 / L, E4 = E / 4, E2 = E / 2, OBB = VC ? 4672 : 5632, BUFB = OBB + 1024, D = NB - 1;
    const int cs = lane % L, rg = lane / L, row0 = rowbase + rg * RR, c0 = cs * E;
    f32x2 S[RR][E2];
#pragma unroll
    for (int i = 0; i < RR; ++i)
#pragma unroll
        for (int e = 0; e < E2; ++e) {
            if (S0) { S[i][e].x = S0[(row0 + i) * 64 + c0 + 2 * e]; S[i][e].y = S0[(row0 + i) * 64 + c0 + 2 * e + 1]; }
            else { S[i][e].x = 0.f; S[i][e].y = 0.f; }
        }
    const float kal = rw_k_a[h * 64 + lane], okal = 1.0f - kal;
    const char* gdec = (const char*)((const float*)(ws + O_DEC) + (size_t)d * M_TOK * 1024 + h * 64);
    const char* gkk = (const char*)((const float*)(ws + O_KK) + h * 64);
    const char* gk = (const char*)((const float*)(ws + O_K) + h * 64);
    const char* gr = (const char*)((const float*)(ws + O_R) + h * 64);
    const char* gv = (const char*)((const float*)(ws + O_V) + h * 64);
    const char* ga = (const char*)((const bf16_t*)(ws + O_ABF) + (size_t)d * M_TOK * 1024 + h * 64);
    unsigned offF, offA, offV;
    { const int s = lane >> 4, t = d ? T - 1 - s : s; offF = (unsigned)(((tok0 + t) * 1024 + (lane & 15) * 4) * 4); }
    { const int s = (lane >> 3) & 3, t = d ? T - 1 - s : s; offA = (unsigned)(((tok0 + t) * 1024 + (lane & 7) * 8) * 2); }
    { const int s = lane & 3, t = d ? T - 1 - s : s; offV = (unsigned)(((tok0 + t) * 1024 + rowbase) * 4); }
    const unsigned dF = d ? (unsigned)(-16384) : 16384u, dA = d ? (unsigned)(-8192) : 8192u;
    bf16_t* gy = (bf16_t*)(ws + O_Y) + (size_t)d * M_TOK * 1024 + h * 64;
    const int nc = T / 4;
    asm volatile("s_waitcnt vmcnt(0)" ::: "memory");
#pragma unroll
    for (int c = 0; c < D; ++c) { scan_issue<VC>(wl + c * BUFB, gdec, gkk, gk, gr, gv, ga, offF, offA, offV, lane); offF += dF; offA += dA; offV += dF; }
    int bi = 0;
    for (int c = 0; c < nc; ++c) {
        if (c + D <= nc) {
            if (D == 1) asm volatile("s_waitcnt vmcnt(0)" ::: "memory");
            else if (D == 2) asm volatile("s_waitcnt vmcnt(6)" ::: "memory");
            else if (D == 3) asm volatile("s_waitcnt vmcnt(12)" ::: "memory");
            else asm volatile("s_waitcnt vmcnt(18)" ::: "memory");
        } else asm volatile("s_waitcnt vmcnt(0)" ::: "memory");
        if (VC ? ((c & 15) == 0 && c > 0) : (c > 0)) {
            const int i = VC ? (c - 16) * 4 + lane : (c - 1) * 4 + (lane >> 4), t = d ? T - 1 - i : i;
            const u32x2 yv = *(const LAS u32x2*)(ys + lane * 8);
            *(u32x2*)(gy + (size_t)(tok0 + t) * 1024 + (VC ? rowbase : (lane & 15) * 4)) = yv;
        }
        if (c + D < nc) { int bn = bi + D; if (bn >= NB) bn -= NB; scan_issue<VC>(wl + bn * BUFB, gdec, gkk, gk, gr, gv, ga, offF, offA, offV, lane); offF += dF; offA += dA; offV += dF; }
        LAS unsigned char* b = wl + bi * BUFB;
        if (++bi == NB) bi = 0;
#pragma unroll
        for (int s = 0; s < 4; ++s) {
            const float kkv = *(const LAS float*)(b + 1024 + s * 256 + lane * 4);
            const float kv = *(const LAS float*)(b + 2048 + s * 256 + lane * 4);
            const float av = __uint_as_float(((unsigned)*(const LAS unsigned short*)(b + 4096 + s * 128 + lane * 2)) << 16);
            *(LAS float*)(b + OBB + s * 256 + lane * 4) = kkv * av;
            *(LAS float*)(b + 2048 + s * 256 + lane * 4) = kv * (av * kal + okal);
        }
        asm volatile("s_waitcnt lgkmcnt(0)" ::: "memory");
#define SCAN_STEP(W_, KK_, KD_, R_, BB_, VI_, s_) do { \
            float yo[RR]; \
            _Pragma("unroll") for (int ri = 0; ri < RR; ++ri) { \
                const float vi = (VI_)[ri]; \
                f32x2 acc2 = {0.f, 0.f}; \
                _Pragma("unroll") for (int e = 0; e < E2; ++e) { const f32x2 kk2 = {(KK_)[e >> 1][(e & 1) * 2], (KK_)[e >> 1][(e & 1) * 2 + 1]}; acc2 = S[ri][e] * kk2 + acc2; } \
                const float sa = redL<L>(acc2.x + acc2.y); \
                f32x2 y2 = {0.f, 0.f}; \
                _Pragma("unroll") for (int e = 0; e < E2; ++e) { \
                    const f32x2 kd2 = {(KD_)[e >> 1][(e & 1) * 2], (KD_)[e >> 1][(e & 1) * 2 + 1]}, bb2 = {(BB_)[e >> 1][(e & 1) * 2], (BB_)[e >> 1][(e & 1) * 2 + 1]}; \
                    const f32x2 w2 = {(W_)[e >> 1][(e & 1) * 2], (W_)[e >> 1][(e & 1) * 2 + 1]}, r2 = {(R_)[e >> 1][(e & 1) * 2], (R_)[e >> 1][(e & 1) * 2 + 1]}; \
                    const f32x2 tt = kd2 * vi - bb2 * sa; \
                    S[ri][e] = S[ri][e] * w2 + tt; \
                    y2 = S[ri][e] * r2 + y2; \
                } \
                yo[ri] = redL<L>(y2.x + y2.y); \
            } \
            if (cs == 0) {   \
                if (RR == 4) { u32x2 pk; pk.x = cvt_pk_bf16(yo[0], yo[1]); pk.y = cvt_pk_bf16(yo[2], yo[RR - 1]); *(LAS u32x2*)(ys + ((s_) * 16 + rg) * 8) = pk; } \
                else *(LAS bf16_t*)(ys + (((c & 15) * 4 + (s_)) * 8) + rg * 2) = (bf16_t)(cvt_pk_bf16(yo[0], yo[0]) & 0xffffu); \
            } } while (0)
        if constexpr (VC) {
            f32x4 W[4][E4], KK[4][E4], KD[4][E4], R[4][E4], BB[4][E4]; float VI[4][RR];
#pragma unroll
            for (int s = 0; s < 4; ++s) {
#pragma unroll
                for (int e = 0; e < E4; ++e) {
                    W[s][e] = *(const LAS f32x4*)(b + 0 + s * 256 + c0 * 4 + e * 16);
                    KK[s][e] = *(const LAS f32x4*)(b + 1024 + s * 256 + c0 * 4 + e * 16);
                    KD[s][e] = *(const LAS f32x4*)(b + 2048 + s * 256 + c0 * 4 + e * 16);
                    R[s][e] = *(const LAS f32x4*)(b + 3072 + s * 256 + c0 * 4 + e * 16);
                    BB[s][e] = *(const LAS f32x4*)(b + OBB + s * 256 + c0 * 4 + e * 16);
                }
#pragma unroll
                for (int ri = 0; ri < RR; ++ri) VI[s][ri] = *(const LAS float*)(b + 4608 + s * 16 + (row0 + ri - rowbase) * 4);
            }
            asm volatile("s_waitcnt lgkmcnt(0)" ::: "memory");
            float yp4[4];
#pragma unroll
            for (int s = 0; s < 4; ++s) {
                const f32x2 kkA = {KK[s][0][0], KK[s][0][1]}, kkB = {KK[s][0][2], KK[s][0][3]};
                const f32x2 acc2 = S[0][1] * kkB + S[0][0] * kkA;
                const float sa = redL<L>(acc2.x + acc2.y);
                const float vi = VI[s][0];
                const f32x2 kdA = {KD[s][0][0], KD[s][0][1]}, kdB = {KD[s][0][2], KD[s][0][3]}, bbA = {BB[s][0][0], BB[s][0][1]}, bbB = {BB[s][0][2], BB[s][0][3]};
                const f32x2 wA = {W[s][0][0], W[s][0][1]}, wB = {W[s][0][2], W[s][0][3]}, rA = {R[s][0][0], R[s][0][1]}, rB = {R[s][0][2], R[s][0][3]};
                const f32x2 uA = kdA * vi, uB = kdB * vi;
                S[0][0] = S[0][0] * wA + (uA - bbA * sa);
                S[0][1] = S[0][1] * wB + (uB - bbB * sa);
                const f32x2 y2 = S[0][1] * rB + S[0][0] * rA;
                yp4[s] = y2.x + y2.y;
            }
#pragma unroll
            for (int s = 0; s < 4; ++s) yp4[s] = redL<L>(yp4[s]);
            if (cs == 0) {
                u32x2 pk; pk.x = cvt_pk_bf16(yp4[0], yp4[1]); pk.y = cvt_pk_bf16(yp4[2], yp4[3]);
                LAS bf16_t* yq = (LAS bf16_t*)(ys + ((c & 15) * 4) * 8 + rg * 2);
                yq[0] = (bf16_t)(pk.x & 0xffffu); yq[4] = (bf16_t)(pk.x >> 16); yq[8] = (bf16_t)(pk.y & 0xffffu); yq[12] = (bf16_t)(pk.y >> 16);
            }
        } else {
#pragma unroll 2
            for (int s = 0; s < 4; ++s) {
                f32x4 w[E4], kk[E4], kd[E4], r[E4], bb[E4]; float vv[RR];
#pragma unroll
                for (int e = 0; e < E4; ++e) {
                    w[e] = *(const LAS f32x4*)(b + 0 + s * 256 + c0 * 4 + e * 16);
                    kk[e] = *(const LAS f32x4*)(b + 1024 + s * 256 + c0 * 4 + e * 16);
                    kd[e] = *(const LAS f32x4*)(b + 2048 + s * 256 + c0 * 4 + e * 16);
                    r[e] = *(const LAS f32x4*)(b + 3072 + s * 256 + c0 * 4 + e * 16);
                    bb[e] = *(const LAS f32x4*)(b + OBB + s * 256 + c0 * 4 + e * 16);
                }
#pragma unroll
                for (int ri = 0; ri < RR; ++ri) vv[ri] = *(const LAS float*)(b + 4608 + s * 256 + (row0 + ri) * 4);
                SCAN_STEP(w, kk, kd, r, bb, vv, s);
            }
        }
#undef SCAN_STEP
    }
    {
        const int i = VC ? (nc - 16) * 4 + lane : (nc - 1) * 4 + (lane >> 4), t = d ? T - 1 - i : i;
        const u32x2 yv = *(const LAS u32x2*)(ys + lane * 8);
        *(u32x2*)(gy + (size_t)(tok0 + t) * 1024 + (VC ? rowbase : (lane & 15) * 4)) = yv;
    }
    if (Sout) {
#pragma unroll
        for (int i = 0; i < RR; ++i)
#pragma unroll
            for (int e = 0; e < E2; ++e) *(f32x2*)(Sout + (row0 + i) * 64 + c0 + 2 * e) = S[i][e];
    }
    asm volatile("s_waitcnt vmcnt(0)" ::: "memory");
}


#define XB_TMO      128
#define XB_XCNT(j)  (256  + 64 * (j))
#define XB_XSUB(j)  (1280 + 64 * (j))
#define XB_XGEN(j)  (2304 + 64 * (j))
#define XB_TOP      3328
#define XB_TOPGEN   3392
#define XCD_BAR_WORDS 3456
#define XB_SPIN_CAP (1u << 18)
__device__ __forceinline__ unsigned xb_ld(unsigned* p)              { return __hip_atomic_load(p, __ATOMIC_RELAXED, __HIP_MEMORY_SCOPE_AGENT); }
__device__ __forceinline__ unsigned xb_add(unsigned* p, unsigned v) { return __hip_atomic_fetch_add(p, v, __ATOMIC_RELAXED, __HIP_MEMORY_SCOPE_AGENT); }
__device__ __forceinline__ unsigned xb_xcc_id() { return (unsigned)__builtin_amdgcn_s_getreg((3 << 11) | 20) & 0xFu; }
#define XB_SPIN(cond, bar) do { unsigned _sp = 0; while (cond) { __builtin_amdgcn_s_sleep(1); \
    if ((++_sp & 255u) == 0u) { if (xb_ld(&(bar)[XB_TMO])) break; if (_sp > XB_SPIN_CAP) { atomicAdd(&(bar)[XB_TMO], 1u); break; } } } } while (0)
struct XcdBarrier { unsigned* bar; unsigned x; volatile LAS unsigned* st; };
__device__ __forceinline__ XcdBarrier xcd_barrier_post(unsigned* bar, volatile LAS unsigned* st) {
    XcdBarrier b; b.bar = bar; b.x = xb_xcc_id(); b.st = st;
    if (threadIdx.x == 0) (void)xb_add(&bar[XB_XCNT(b.x)], 1u);
    return b;
}
__device__ __forceinline__ void xcd_barrier_complete(unsigned* bar, unsigned x, unsigned& nloc, unsigned& nx) {
    const unsigned G = gridDim.x * gridDim.y * gridDim.z;
    unsigned sum, cnt, mine, sp = 0u;
    for (;;) {
        sum = 0u; cnt = 0u; mine = 0u;
#pragma unroll
        for (unsigned j = 0; j < 16; ++j) { const unsigned c = xb_ld(&bar[XB_XCNT(j)]); sum += c; cnt += (c > 0u) ? 1u : 0u; mine = (j == x) ? c : mine; }
        if (sum == G) break;
        __builtin_amdgcn_s_sleep(1);
        if ((++sp & 255u) == 0u) { if (xb_ld(&bar[XB_TMO])) break; if (sp > XB_SPIN_CAP) { atomicAdd(&bar[XB_TMO], 1u); break; } }
    }
    nloc = mine > 0u ? mine : 1u; nx = cnt > 0u ? cnt : 1u;
}
__device__ __forceinline__ void xcd_barrier(const XcdBarrier& b) {
    asm volatile("s_waitcnt vmcnt(0)" ::: "memory");
    __syncthreads();
    if (threadIdx.x == 0) {
        unsigned* bar = b.bar;
        __builtin_amdgcn_s_waitcnt(0);
        unsigned nloc = b.st[0], nx = b.st[1];
        if (nloc == 0u) { xcd_barrier_complete(bar, b.x, nloc, nx); b.st[0] = nloc; b.st[1] = nx; }
        const unsigned old = xb_add(&bar[XB_XSUB(b.x)], 1u);
        const unsigned gen = old / nloc;
        if (old + 1u == (gen + 1u) * nloc) {
            __builtin_amdgcn_fence(__ATOMIC_RELEASE, "agent");
            asm volatile("s_waitcnt vmcnt(0)" ::: "memory");
            const unsigned og = xb_add(&bar[XB_TOP], 1u);
            const unsigned tg = og / nx;
            if (og + 1u == (tg + 1u) * nx) xb_add(&bar[XB_TOPGEN], 1u);
            else XB_SPIN(xb_ld(&bar[XB_TOPGEN]) == tg, bar);
            __builtin_amdgcn_fence(__ATOMIC_ACQUIRE, "agent");
            xb_add(&bar[XB_XGEN(b.x)], 1u);
            asm volatile("s_waitcnt vmcnt(0)" ::: "memory");
        } else {
            XB_SPIN(xb_ld(&bar[XB_XGEN(b.x)]) == gen, bar);
            __builtin_amdgcn_fence(__ATOMIC_ACQUIRE, "agent");
            asm volatile("s_waitcnt vmcnt(0)" ::: "memory");
        }
    }
    __syncthreads();
}
constexpr size_t O_BAR = 229376;
constexpr int LDS_XB = 132096;

extern __shared__ __attribute__((aligned(16))) unsigned char shm[];

template <int ph> __device__ __forceinline__ void run_phase(const Params& p) {
    const int tid = threadIdx.x, lane = tid & 63, wid = tid >> 6;
    unsigned char* ws = p.ws;
    LAS unsigned char* lds = (LAS unsigned char*)shm;
    float* mod = (float*)(ws + O_MOD);
    {
        switch (ph) {
        case 0: {
            float* sc = (float*)shm;
            float* red = (float*)(shm + 24576);
            for (int i = tid; i < 3 * DM; i += 512) {
                const int ci = i / DM, k = i % DM;
                const float cv = ci == 0 ? p.in[5][k] : p.in[2][(ci - 1) * DM + k];
                sc[i] = cv * sigmoidf_(cv);
            }
            __syncthreads();
            for (int item = blockIdx.x; item < NMOD / 64; item += gridDim.x) {
                const int j0 = item * 64, jq = tid & 15, ks = tid >> 4;
                f32x4 a0 = {0.f, 0.f, 0.f, 0.f}, a1 = a0, a2 = a0;
                const float* wp = p.in[6] + (size_t)(ks * 64) * NMOD + j0 + jq * 4;
#pragma unroll 16
                for (int k = 0; k < 64; ++k) {
                    const f32x4 w = ld4(wp + (size_t)k * NMOD);
                    a0 += w * sc[ks * 64 + k]; a1 += w * sc[DM + ks * 64 + k]; a2 += w * sc[2 * DM + ks * 64 + k];
                }
                st4(red + ((ks * 3 + 0) * 16 + jq) * 4, a0); st4(red + ((ks * 3 + 1) * 16 + jq) * 4, a1); st4(red + ((ks * 3 + 2) * 16 + jq) * 4, a2);
                __syncthreads();
                if (tid < 48) {
                    const int ci = tid >> 4, q = tid & 15;
                    f32x4 s = ld4(p.in[7] + j0 + q * 4);
                    for (int k2 = 0; k2 < 32; ++k2) s += ld4(red + ((k2 * 3 + ci) * 16 + q) * 4);
                    st4(mod + (size_t)ci * NMOD + j0 + q * 4, s);
                }
                __syncthreads();
            }
            conv_T<1>(p.in[10], DM, 2 * DFF, (bf16_t*)(ws + WF_IN), shm, 0, gridDim.x);
        } break;
        case 1: {
            bf16_t* A = (bf16_t*)(ws + O_ABUF);
            const size_t ngrp = (size_t)M_TOK * 256, stride = (size_t)gridDim.x * 512;
            for (size_t g0 = (size_t)blockIdx.x * 512 + tid; g0 < ngrp; g0 += 4 * stride) {
                f32x4 xa[4], xb[4];
#pragma unroll
                for (int j = 0; j < 4; ++j) {
                    const size_t gidx = g0 + j * stride;
                    xa[j] = (f32x4){0.f, 0.f, 0.f, 0.f}; xb[j] = xa[j];
                    if (gidx < ngrp) {
                        const int row = (int)(gidx >> 8), c = (int)(gidx & 255) * 8;
                        const float* x = row < M_CTX ? p.in[0] + (size_t)row * DM : p.in[1] + (size_t)(row - M_CTX) * DM;
                        xa[j] = ld4(x + c); xb[j] = ld4(x + c + 4);
                    }
                }
#pragma unroll
                for (int j = 0; j < 4; ++j) {
                    const size_t gidx = g0 + j * stride;
                    if (gidx < ngrp) {
                        const int row = (int)(gidx >> 8), c = (int)(gidx & 255) * 8;
                        const float* md = mod + (size_t)cond_of_row(row) * NMOD;
                        const f32x4 v0 = xa[j] * (ld4(md + DM + c) + 1.0f) + ld4(md + c), v1 = xb[j] * (ld4(md + DM + c + 4) + 1.0f) + ld4(md + c + 4);
                        u32x4 w; w.x = cvt_pk_bf16(v0[0], v0[1]); w.y = cvt_pk_bf16(v0[2], v0[3]); w.z = cvt_pk_bf16(v1[0], v1[1]); w.w = cvt_pk_bf16(v1[2], v1[3]);
                        *(u32x4*)(A + (size_t)row * DM + c) = w;
                    }
                }
            }
        } break;
        case 2: case 14: {
            pg8::Gemm g{(const bf16_t*)(ws + O_ABUF), (const bf16_t*)(ws + (ph == 14 ? WF2_IN : WF_IN)), M_TOK, 2 * DFF, DM, DM};
            pg8::StaticOrder S; S.init(M_TOK, 2 * DFF, gridDim.x, blockIdx.x);
            EpiSwiglu E{(bf16_t*)(ws + O_HID)};
            pg8::gemm_phase(lds, g, S, E);
            if (ph == 2) {
                const int i0 = 2064 % (int)gridDim.x;
                if ((int)blockIdx.x >= i0) { __syncthreads(); conv_T<0>(p.in[11], DFF, DM, (bf16_t*)(ws + WF_OUT), shm, i0, gridDim.x - i0); }
            }
        } break;
        case 3: case 12: case 15: {
            pg8::Gemm g; EpiResid<(ph != 3)> E;
            if (ph == 12) {
                g = pg8::Gemm{(const bf16_t*)(ws + O_ABUF), (const bf16_t*)(ws + WM_O), M_TOK, DM, DM, DM};
                E = EpiResid<(ph != 3)>{(const float*)(ws + O_XRES), (const float*)(ws + O_XRES), mod, 5, 1.0f, (bf16_t*)(ws + O_M1)};
            } else {
                g = pg8::Gemm{(const bf16_t*)(ws + O_HID), (const bf16_t*)(ws + (ph == 15 ? WF2_OUT : WF_OUT)), M_TOK, DM, DFF, DFF};
                if (ph == 3) E = EpiResid<(ph != 3)>{p.in[0], p.in[1] - (size_t)M_CTX * DM, mod, 2, 0.5f, (bf16_t*)(ws + O_PRE)};
                else E = EpiResid<(ph != 3)>{(const float*)(ws + O_XRES), (const float*)(ws + O_XRES), mod, 8, 0.5f, (bf16_t*)(ws + O_PRE)};
            }
            if (ph == 15 && gridDim.x == 256) {
                { g.M = 8192; pg8::StaticOrder S1; S1.init(8192, DM, 256, blockIdx.x); pg8::gemm_phase(lds, g, S1, E); }
                pg8::StaticOrder S2; S2.init(4096, DM, 128, blockIdx.x & 127);
                if (blockIdx.x < 128) {
                    pg8::Gemm g2{(const bf16_t*)(ws + O_HID) + (size_t)8192 * DFF, (const bf16_t*)(ws + WF2_OUT), 4096, DM, 2816, DFF, DFF};
                    EpiResidSplit<0> E2{(const float*)(ws + O_XRES), mod, (bf16_t*)(ws + O_PRE)};
                    pg8::gemm_phase(lds, g2, S2, E2);
                } else {
                    pg8::Gemm g2{(const bf16_t*)(ws + O_HID) + (size_t)8192 * DFF + 2816, (const bf16_t*)(ws + WF2_OUT) + 2816, 4096, DM, 2688, DFF, DFF};
                    EpiResidSplit<1> E2{(const float*)(ws + O_XRES), mod, (bf16_t*)(ws + O_PREB)};
                    pg8::gemm_phase(lds, g2, S2, E2);
                }
            } else {
            pg8::StaticOrder S; S.init(M_TOK, DM, gridDim.x, blockIdx.x);
            pg8::gemm_phase(lds, g, S, E);
            }
            if (ph == 3 || ph == 12) {
                int i0 = 384 - (int)gridDim.x; if (i0 < 0 || i0 >= (int)gridDim.x) i0 = 0;
                if ((int)blockIdx.x >= i0) {
                    __syncthreads();
                    if (ph == 3) {
                        conv_T<2>(p.in[12], DM, 9504, (bf16_t*)(ws + WM_IN), shm, i0, gridDim.x - i0);
                        conv_T<0>(p.in[28], DA, DM, (bf16_t*)(ws + WM_PA), shm, i0, gridDim.x - i0);
                    } else conv_T<0>(p.in[11] + (size_t)DFF * DM, DFF, DM, (bf16_t*)(ws + WF2_OUT), shm, i0, gridDim.x - i0);
                }
            }
        } break;
        case 4: case 13: case 16: {
            const int li = ph == 4 ? 0 : ph == 13 ? 1 : 2;
            const bf16_t* pre = (const bf16_t*)(ws + (ph == 13 ? O_M1 : O_PRE));
            if (ph == 16) ln_rows<true>(pre, p.in[8] + li * DM, p.in[9] + li * DM, p.out, nullptr, mod, 0, gridDim.x == 256 ? (const bf16_t*)(ws + O_PREB) : nullptr);
            else ln_rows<false>(pre, p.in[8] + li * DM, p.in[9] + li * DM, (float*)(ws + O_XRES), (bf16_t*)(ws + O_ABUF), mod, li + 1);
            if (ph == 4) {
                conv_T<0>(p.in[29], DA, DM, (bf16_t*)(ws + WM_PB), shm, 0, gridDim.x);
                conv_T<0>(p.in[30], DM, DM, (bf16_t*)(ws + WM_O), shm, 0, gridDim.x);
                bf16_t* wl = (bf16_t*)(ws + WM_L);
                for (int idx = blockIdx.x * 512 + tid; idx < 5120 * 48; idx += gridDim.x * 512) {
                    const int n = idx % 5120, kc = (idx / 5120) * 8, sec = n >> 10, c = n & 1023;
                    float v[8];
#pragma unroll
                    for (int j = 0; j < 8; ++j) {
                        const int k = kc + j; float x = 0.f;
                        if (sec < 2) { if (k < 64) x = p.in[15][((size_t)sec * 64 + k) * 1024 + c]; }
                        else if (sec < 4) { if (k >= 64 && k < 128) x = p.in[17][((size_t)(sec - 2) * 64 + (k - 64)) * 1024 + c]; }
                        else { if (k >= 128 && k < 288) x = p.in[18][(size_t)(k - 128) * 1024 + c]; }
                        v[j] = x;
                    }
                    u32x4 w; w.x = cvt_pk_bf16(v[0], v[1]); w.y = cvt_pk_bf16(v[2], v[3]); w.z = cvt_pk_bf16(v[4], v[5]); w.w = cvt_pk_bf16(v[6], v[7]);
                    *(u32x4*)(wl + (size_t)n * KL + kc) = w;
                }
            }
        } break;
        case 5: {
            pg8::Gemm g{(const bf16_t*)(ws + O_ABUF), (const bf16_t*)(ws + WM_IN), M_TOK, 5632, DM, DM};
            pg8::StaticOrder S; S.init(M_TOK, 5632, gridDim.x, blockIdx.x);
            EpiProj E{(bf16_t*)(ws + O_ZS), (bf16_t*)(ws + O_UV)};
            pg8::gemm_phase(lds, g, S, E);
        } break;
        case 6: {
            const bf16_t* zs = (const bf16_t*)(ws + O_ZS); const float* mu = p.in[13];
            float* R = (float*)(ws + O_R); float* Kq = (float*)(ws + O_K); float* V = (float*)(ws + O_V); float* KK = (float*)(ws + O_KK);
            bf16_t* LB = (bf16_t*)(ws + O_LB); bf16_t* UV = (bf16_t*)(ws + O_UV);
            for (int row = blockIdx.x * 8 + wid; row < M_TOK; row += gridDim.x * 8) {
                const bool lat = row >= M_CTX;
                int r0, r1, r2 = row, r3 = row; float f0, f1, f2 = 0.f, f3 = 0.f, wgt;
                if (!lat) { const int t = row & 255; r0 = t > 0 ? row - 1 : row; f0 = t > 0 ? 1.f : 0.f; r1 = t < 255 ? row + 1 : row; f1 = t < 255 ? 1.f : 0.f; wgt = 0.5f; }
                else {
                    const int q = (row - M_CTX) & 2047, gr = q >> 6, gc = q & 63;
                    r0 = gr > 0 ? row - 64 : row; f0 = gr > 0 ? 1.f : 0.f; r1 = gr < 31 ? row + 64 : row; f1 = gr < 31 ? 1.f : 0.f;
                    r2 = gc > 0 ? row - 1 : row; f2 = gc > 0 ? 1.f : 0.f; r3 = gc < 63 ? row + 1 : row; f3 = gc < 63 ? 1.f : 0.f; wgt = 0.25f;
                }
                const bf16_t* z = zs + (size_t)row * NZS; const bf16_t* z0 = zs + (size_t)r0 * NZS; const bf16_t* z1 = zs + (size_t)r1 * NZS;
                const bf16_t* z2 = zs + (size_t)r2 * NZS; const bf16_t* z3 = zs + (size_t)r3 * NZS;
#define SHIFT4(col, res) do { const f32x4 zz = ldbf4(z + (col)); f32x4 nb = ldbf4(z0 + (col)) * f0 + ldbf4(z1 + (col)) * f1; \
                    if (lat) nb += ldbf4(z2 + (col)) * f2 + ldbf4(z3 + (col)) * f3; nb *= wgt; res = zz + ld4(mu + (col)) * (nb - zz); } while (0)
                f32x4 rv[4], kv[4], vv[4]; float ss = 0.f;
                shift16(z, z0, z1, z2, z3, mu, lane * 16, lat, f0, f1, f2, f3, wgt, rv);
                shift16(z, z0, z1, z2, z3, mu, 1024 + lane * 16, lat, f0, f1, f2, f3, wgt, kv);
                shift16(z, z0, z1, z2, z3, mu, 2048 + lane * 16, lat, f0, f1, f2, f3, wgt, vv);
                f32x4 xlo = {0.f, 0.f, 0.f, 0.f}, xgg = xlo;
                if (lane < 32) SHIFT4(3072 + lane * 4, xlo);
                if (lane < 40) SHIFT4(3200 + lane * 4, xgg);
                bf16_t* vp = UV + (size_t)row * 2048 + 1024 + lane * 16;
                const u32x4 w0 = *(const u32x4*)vp, w1 = *(const u32x4*)(vp + 8);
                f32x4 lg[4], lb4[4];
#pragma unroll
                for (int q = 0; q < 4; ++q) { lg[q] = ld4(p.in[24] + lane * 16 + q * 4); lb4[q] = ld4(p.in[25] + lane * 16 + q * 4); }
                __builtin_amdgcn_sched_barrier(0);
#pragma unroll
                for (int q = 0; q < 4; ++q) {
                    const int c = lane * 16 + q * 4;
                    st4(R + (size_t)row * 1024 + c, rv[q]); st4(Kq + (size_t)row * 1024 + c, kv[q]); st4(V + (size_t)row * 1024 + c, vv[q]);
                    const f32x4 kq = kv[q] * ld4(p.in[19] + c);
                    kv[q] = kq; ss += (kq[0] * kq[0] + kq[1] * kq[1]) + (kq[2] * kq[2] + kq[3] * kq[3]);
                }
                ss += __shfl_xor(ss, 1); ss += __shfl_xor(ss, 2);
                const float inv = 1.0f / fmaxf(sqrtf(ss), 1e-12f);
#pragma unroll
                for (int q = 0; q < 4; ++q) st4(KK + (size_t)row * 1024 + lane * 16 + q * 4, kv[q] * inv);
                if (lane < 32) {
                    f32x4 x = xlo;
                    if (lane < 16) { x[0] = tanhf(x[0]); x[1] = tanhf(x[1]); x[2] = tanhf(x[2]); x[3] = tanhf(x[3]); }
                    u32x2 w; w.x = cvt_pk_bf16(x[0], x[1]); w.y = cvt_pk_bf16(x[2], x[3]);
                    *(u32x2*)(LB + (size_t)row * KL + lane * 4) = w;
                }
                if (lane < 40) {
                    const f32x4 x = xgg;
                    u32x2 w; w.x = cvt_pk_bf16(sigmoidf_(x[0]), sigmoidf_(x[1])); w.y = cvt_pk_bf16(sigmoidf_(x[2]), sigmoidf_(x[3]));
                    *(u32x2*)(LB + (size_t)row * KL + 128 + lane * 4) = w;
                } else { u32x2 w; w.x = 0u; w.y = 0u; *(u32x2*)(LB + (size_t)row * KL + 288 + (lane - 40) * 4) = w; }
#undef SHIFT4
                {
                    float x[16] = {bflo(w0.x), bfhi(w0.x), bflo(w0.y), bfhi(w0.y), bflo(w0.z), bfhi(w0.z), bflo(w0.w), bfhi(w0.w),
                                   bflo(w1.x), bfhi(w1.x), bflo(w1.y), bfhi(w1.y), bflo(w1.z), bfhi(w1.z), bflo(w1.w), bfhi(w1.w)};
                    float s = 0.f;
#pragma unroll
                    for (int j = 0; j < 16; ++j) s += x[j];
                    const float m = wsum(s) * (1.0f / 1024.f);
                    float qq = 0.f;
#pragma unroll
                    for (int j = 0; j < 16; ++j) { const float dd = x[j] - m; qq += dd * dd; }
                    const float rstd = rsqrtf(wsum(qq) * (1.0f / 1024.f) + LN_EPS);
                    float o[16];
#pragma unroll
                    for (int j = 0; j < 16; ++j) o[j] = (x[j] - m) * rstd * lg[j >> 2][j & 3] + lb4[j >> 2][j & 3];
                    u32x4 o0, o1;
                    o0.x = cvt_pk_bf16(o[0], o[1]); o0.y = cvt_pk_bf16(o[2], o[3]); o0.z = cvt_pk_bf16(o[4], o[5]); o0.w = cvt_pk_bf16(o[6], o[7]);
                    o1.x = cvt_pk_bf16(o[8], o[9]); o1.y = cvt_pk_bf16(o[10], o[11]); o1.z = cvt_pk_bf16(o[12], o[13]); o1.w = cvt_pk_bf16(o[14], o[15]);
                    *(u32x4*)vp = o0; *(u32x4*)(vp + 8) = o1;
                }
            }
        } break;
        case 7: {
            {
                pg8::Gemm g{(const bf16_t*)(ws + O_LB), (const bf16_t*)(ws + WM_L), M_TOK, 5120, KL, KL};
                pg8::StaticOrder S; S.init(M_TOK, 5120, gridDim.x, blockIdx.x);
                EpiLora E{(float*)(ws + O_DEC), (bf16_t*)(ws + O_ABF), (bf16_t*)(ws + O_G), p.in[14], p.in[16]};
                pg8::gemm_phase(lds, g, S, E);
            }
            __syncthreads();
            {
                bf16_t* vnT = (bf16_t*)shm;
                bf16_t* wsb = (bf16_t*)(shm + 34816);
                bf16_t* UV = (bf16_t*)(ws + O_UV);
                const int fr = lane & 15, fq = lane >> 4;
                for (int item = blockIdx.x; item < 96 * 8; item += gridDim.x) {
                    const int n = item >> 3, gi = item & 7;
#pragma unroll
                    for (int i = 0; i < 4; ++i) {
                        const int ch = tid + i * 512, q = ch >> 4, cc = (ch & 15) * 8;
                        const u32x4 w = *(const u32x4*)(UV + (size_t)(n * 128 + q) * 2048 + 1024 + gi * 128 + cc);
                        vnT[(cc + 0) * 136 + q] = (bf16_t)(w.x & 0xffff); vnT[(cc + 1) * 136 + q] = (bf16_t)(w.x >> 16);
                        vnT[(cc + 2) * 136 + q] = (bf16_t)(w.y & 0xffff); vnT[(cc + 3) * 136 + q] = (bf16_t)(w.y >> 16);
                        vnT[(cc + 4) * 136 + q] = (bf16_t)(w.z & 0xffff); vnT[(cc + 5) * 136 + q] = (bf16_t)(w.z >> 16);
                        vnT[(cc + 6) * 136 + q] = (bf16_t)(w.w & 0xffff); vnT[(cc + 7) * 136 + q] = (bf16_t)(w.w >> 16);
                    }
#pragma unroll
                    for (int i = 0; i < 4; ++i) {
                        const int ch = tid + i * 512, pp = ch >> 4, qq = (ch & 15) * 8;
                        const float* sp = p.in[26] + ((size_t)gi * 128 + pp) * 128 + qq;
                        const f32x4 a = ld4(sp), b = ld4(sp + 4);
                        u32x4 w; w.x = cvt_pk_bf16(a[0], a[1]); w.y = cvt_pk_bf16(a[2], a[3]); w.z = cvt_pk_bf16(b[0], b[1]); w.w = cvt_pk_bf16(b[2], b[3]);
                        *(u32x4*)(wsb + pp * 136 + qq) = w;
                    }
                    __syncthreads();
                    f32x4 acc[8];
#pragma unroll
                    for (int pi = 0; pi < 8; ++pi) acc[pi] = (f32x4){0.f, 0.f, 0.f, 0.f};
#pragma unroll
                    for (int ks = 0; ks < 4; ++ks) {
                        const bf16x8 xf = *(const bf16x8*)(vnT + (wid * 16 + fr) * 136 + ks * 32 + fq * 8);
#pragma unroll
                        for (int pi = 0; pi < 8; ++pi) {
                            const bf16x8 yf = *(const bf16x8*)(wsb + (pi * 16 + fr) * 136 + ks * 32 + fq * 8);
                            acc[pi] = __builtin_amdgcn_mfma_f32_16x16x32_bf16(xf, yf, acc[pi], 0, 0, 0);
                        }
                    }
                    u32x2 uwv[8]; float bsv[8];
#pragma unroll
                    for (int pi = 0; pi < 8; ++pi) {
                        const int pp = pi * 16 + fr;
                        bsv[pi] = p.in[27][gi * 128 + pp];
                        uwv[pi] = *(const u32x2*)(UV + (size_t)(n * 128 + pp) * 2048 + gi * 128 + wid * 16 + fq * 4);
                    }
#pragma unroll
                    for (int pi = 0; pi < 8; ++pi) {
                        const int pp = pi * 16 + fr;
                        const float bs = bsv[pi];
                        bf16_t* up = UV + (size_t)(n * 128 + pp) * 2048 + gi * 128 + wid * 16 + fq * 4;
                        const u32x2 uw = uwv[pi];
                        u32x2 o; o.x = cvt_pk_bf16(bflo(uw.x) * (acc[pi][0] + bs), bfhi(uw.x) * (acc[pi][1] + bs));
                        o.y = cvt_pk_bf16(bflo(uw.y) * (acc[pi][2] + bs), bfhi(uw.y) * (acc[pi][3] + bs));
                        *(u32x2*)up = o;
                    }
                    __syncthreads();
                }
            }
        } break;
        case 8: {
            if (wid < 4) {
                __builtin_amdgcn_s_setprio(3);
                LAS unsigned char* wl = lds + wid * (3 * 5696);
                for (int li = blockIdx.x * 4 + wid; li < 1024; li += gridDim.x * 4) {
                    const int d = li & 1, rb = (li >> 1) & 15, h = (li >> 5) & 15, sq = li >> 9;
                    const float* S0 = (d ? p.in[4] : p.in[3]) + (size_t)(sq * 16 + h) * 4096;
                    scan_run<1, 16, 3, true>(ws, p.in[20], wl, lds + 121600 + wid * 512, M_CTX + sq * 2048, 2048, h, d, rb * 4, S0, nullptr, lane);
                }
                __builtin_amdgcn_s_setprio(0);
            } else {
                LAS unsigned char* wl = lds + 4 * (3 * 5696) + (wid - 4) * (2 * 6656);
                for (int ci = blockIdx.x * 4 + (wid - 4); ci < 1024; ci += gridDim.x * 4) {
                    const int d = ci & 1, h = (ci >> 1) & 15, sq = ci >> 5;
                    float* So = p.out + (d ? OUT_SB : OUT_SF) + (size_t)(sq * 16 + h) * 4096;
                    scan_run<4, 4, 2, false>(ws, p.in[20], wl, lds + 121600 + wid * 512, sq * 256, 256, h, d, 0, nullptr, So, lane);
                }
            }
        } break;
        case 9: {
            const bf16_t* Y = (const bf16_t*)(ws + O_Y); const float* R = (const float*)(ws + O_R); const float* Kq = (const float*)(ws + O_K); const float* V = (const float*)(ws + O_V);
            const bf16_t* AB = (const bf16_t*)(ws + O_ABF); bf16_t* G = (bf16_t*)(ws + O_G);

            const int c0 = lane * 16;
            f32x4 kac[4], rkc[4], gngc[4], gnbc[4];
#pragma unroll
            for (int q = 0; q < 4; ++q) { kac[q] = ld4(p.in[20] + c0 + q * 4); rkc[q] = ld4(p.in[21] + c0 + q * 4); gngc[q] = ld4(p.in[22] + c0 + q * 4); gnbc[q] = ld4(p.in[23] + c0 + q * 4); }
            for (int row = blockIdx.x * 8 + wid; row < M_TOK; row += gridDim.x * 8) {
                float y[16], kx[16], rx[16];
                float s = 0.f;
#pragma unroll
                for (int hh = 0; hh < 2; ++hh) {
                    const u32x4 ya = *(const u32x4*)(Y + (size_t)row * 1024 + c0 + hh * 8), yb = *(const u32x4*)(Y + ((size_t)M_TOK + row) * 1024 + c0 + hh * 8);
                    y[hh * 8 + 0] = bflo(ya.x) + bflo(yb.x); y[hh * 8 + 1] = bfhi(ya.x) + bfhi(yb.x); y[hh * 8 + 2] = bflo(ya.y) + bflo(yb.y); y[hh * 8 + 3] = bfhi(ya.y) + bfhi(yb.y);
                    y[hh * 8 + 4] = bflo(ya.z) + bflo(yb.z); y[hh * 8 + 5] = bfhi(ya.z) + bfhi(yb.z); y[hh * 8 + 6] = bflo(ya.w) + bflo(yb.w); y[hh * 8 + 7] = bfhi(ya.w) + bfhi(yb.w);
                }
#pragma unroll
                for (int j = 0; j < 16; ++j) s += y[j];
                s += __shfl_xor(s, 1); s += __shfl_xor(s, 2);
                const float m = s * (1.0f / 64.f);
                float qq = 0.f;
#pragma unroll
                for (int j = 0; j < 16; ++j) { const float dd = y[j] - m; qq += dd * dd; }
                qq += __shfl_xor(qq, 1); qq += __shfl_xor(qq, 2);
                const float rstd = rsqrtf(qq * (1.0f / 64.f) + GN_EPS);
#pragma unroll
                for (int q = 0; q < 4; ++q) {
                    const f32x4 t = ld4(Kq + (size_t)row * 1024 + c0 + q * 4), u = ld4(R + (size_t)row * 1024 + c0 + q * 4);
                    kx[q * 4] = t[0]; kx[q * 4 + 1] = t[1]; kx[q * 4 + 2] = t[2]; kx[q * 4 + 3] = t[3];
                    rx[q * 4] = u[0]; rx[q * 4 + 1] = u[1]; rx[q * 4 + 2] = u[2]; rx[q * 4 + 3] = u[3];
                }
                float coef = 0.f;
#pragma unroll
                for (int d = 0; d < 2; ++d) {
                    const bf16_t* ap = AB + ((size_t)d * M_TOK + row) * 1024 + c0;
                    const u32x4 w0 = *(const u32x4*)ap, w1 = *(const u32x4*)(ap + 8);
                    const float av[16] = {bflo(w0.x), bfhi(w0.x), bflo(w0.y), bfhi(w0.y), bflo(w0.z), bfhi(w0.z), bflo(w0.w), bfhi(w0.w),
                                          bflo(w1.x), bfhi(w1.x), bflo(w1.y), bfhi(w1.y), bflo(w1.z), bfhi(w1.z), bflo(w1.w), bfhi(w1.w)};
#pragma unroll
                    for (int j = 0; j < 16; ++j) {
                        const float ka = kac[j >> 2][j & 3];
                        coef += rx[j] * kx[j] * (1.0f + (av[j] - 1.0f) * ka) * rkc[j >> 2][j & 3];
                    }
                }
                coef += __shfl_xor(coef, 1); coef += __shfl_xor(coef, 2);
                bf16_t* gp = G + (size_t)row * 1024 + c0;
                const u32x4 g0 = *(const u32x4*)gp, g1 = *(const u32x4*)(gp + 8);
                const float gv[16] = {bflo(g0.x), bfhi(g0.x), bflo(g0.y), bfhi(g0.y), bflo(g0.z), bfhi(g0.z), bflo(g0.w), bfhi(g0.w),
                                      bflo(g1.x), bfhi(g1.x), bflo(g1.y), bfhi(g1.y), bflo(g1.z), bfhi(g1.z), bflo(g1.w), bfhi(g1.w)};
                float o[16];
#pragma unroll
                for (int q = 0; q < 4; ++q) {
                    const f32x4 vv = ld4(V + (size_t)row * 1024 + c0 + q * 4);
#pragma unroll
                    for (int j = 0; j < 4; ++j) {
                        const int jj = q * 4 + j;
                        const float yn = (y[jj] - m) * rstd * gngc[q][j] + gnbc[q][j];
                        o[jj] = (yn + coef * vv[j]) * gv[jj];
                    }
                }
                u32x4 o0, o1;
                o0.x = cvt_pk_bf16(o[0], o[1]); o0.y = cvt_pk_bf16(o[2], o[3]); o0.z = cvt_pk_bf16(o[4], o[5]); o0.w = cvt_pk_bf16(o[6], o[7]);
                o1.x = cvt_pk_bf16(o[8], o[9]); o1.y = cvt_pk_bf16(o[10], o[11]); o1.z = cvt_pk_bf16(o[12], o[13]); o1.w = cvt_pk_bf16(o[14], o[15]);
                *(u32x4*)gp = o0; *(u32x4*)(gp + 8) = o1;
            }
        } break;
        case 10: {
            pg8::Gemm g{(const bf16_t*)(ws + O_ABUF), (const bf16_t*)(ws + WM_IN) + (size_t)5632 * DM, M_TOK, 4096, DM, DM};
            pg8::StaticOrder S; S.init(M_TOK, 4096, gridDim.x, blockIdx.x);
            EpiGates E{(bf16_t*)(ws + O_GTS)};
            pg8::gemm_phase(lds, g, S, E);
        } break;
        case 11: {
            pg8::StaticOrder S; S.init(M_TOK, DM, gridDim.x, blockIdx.x);
            {
                pg8::Gemm g{(const bf16_t*)(ws + O_G), (const bf16_t*)(ws + WM_PA), M_TOK, DM, DA, DA};
                EpiMerge<0> E{(const bf16_t*)(ws + O_GTS), (float*)(ws + O_M1), (bf16_t*)(ws + O_ABUF)};
                pg8::gemm_phase(lds, g, S, E);
            }
            {
                pg8::Gemm g{(const bf16_t*)(ws + O_UV), (const bf16_t*)(ws + WM_PB), M_TOK, DM, DA, 2048};
                EpiMerge<1> E{(const bf16_t*)(ws + O_GTS), (float*)(ws + O_M1), (bf16_t*)(ws + O_ABUF)};
                pg8::gemm_phase(lds, g, S, E);
            }
            {
                int i0 = 384 - (int)gridDim.x; if (i0 < 0 || i0 >= (int)gridDim.x) i0 = 0;
                if ((int)blockIdx.x >= i0) { __syncthreads(); conv_T<1>(p.in[10] + (size_t)DM * 2 * DFF, DM, 2 * DFF, (bf16_t*)(ws + WF2_IN), shm, i0, gridDim.x - i0); }
            }
        } break;
        default: break;
        }
    }
}

__global__ void __launch_bounds__(512) mega(Params p, int ph_lo, int ph_hi) {
    cg::grid_group grid = cg::this_grid();
    volatile LAS unsigned* xst = (volatile LAS unsigned*)((LAS unsigned char*)shm + LDS_XB);
    if (threadIdx.x == 0) { xst[0] = 0u; xst[1] = 0u; }
    __syncthreads();
    const XcdBarrier xb = xcd_barrier_post((unsigned*)(p.ws + O_BAR), xst);
    if (ph_lo > ph_hi) grid.sync();
#define RUNPH(n) if (ph_lo <= (n) && (n) < ph_hi) { if ((n) > ph_lo) xcd_barrier(xb); run_phase<n>(p); }
    RUNPH(0) RUNPH(1) RUNPH(2) RUNPH(3) RUNPH(4) RUNPH(5) RUNPH(6) RUNPH(7) RUNPH(8) RUNPH(9) if (ph_lo <= 10 && 10 < ph_hi) run_phase<10>(p);      RUNPH(11) RUNPH(12) RUNPH(13) RUNPH(14) RUNPH(15) RUNPH(16)
#undef RUNPH
}


#ifdef DBG_STOP
__global__ void dbg_copy(const float* src, size_t nsrc, float* out, size_t nout) {
    for (size_t i = (size_t)blockIdx.x * blockDim.x + threadIdx.x; i < nout; i += (size_t)gridDim.x * blockDim.x) out[i] = 0.f;
}
__global__ void dbg_stat(const unsigned short* src, size_t n, float* out, unsigned* cnt) {
    unsigned local = 0;
    for (size_t i = (size_t)blockIdx.x * blockDim.x + threadIdx.x; i < n; i += (size_t)gridDim.x * blockDim.x) {
        const float v = __uint_as_float(((unsigned)src[i]) << 16);
        if (!(fabsf(v) <= DBG_THR)) ++local;
    }
    if (local) atomicAdd(cnt, local);
}
__global__ void dbg_fin(float* out, const unsigned* cnt, double n) { out[0] = cnt[0] ? 100.0f + 100000.0f * (float)((double)cnt[0] / n) : 0.f; }
#endif

extern "C" void kernel_launch(void* const* d_in, const int* in_sizes, int n_in, void* d_out, int out_size, void* d_ws, size_t ws_size, hipStream_t stream) {
    static int grid_blocks = 0;
    if (!grid_blocks) {
        hipFuncSetAttribute((const void*)mega, hipFuncAttributeMaxDynamicSharedMemorySize, LDS_BYTES);
        int dev = 0, cus = 0, per_cu = 0;
        hipGetDevice(&dev);
        hipDeviceGetAttribute(&cus, hipDeviceAttributeMultiprocessorCount, dev);
        hipOccupancyMaxActiveBlocksPerMultiprocessor(&per_cu, mega, 512, LDS_BYTES);
        if (per_cu > 1) per_cu = 1;
        grid_blocks = cus * per_cu;
        if (grid_blocks <= 0) grid_blocks = 256;
    }
    if (ws_size < WS_NEED) { fprintf(stderr, "workspace too small: %zu < %zu\n", ws_size, (size_t)WS_NEED); return; }
    Params p{};
    for (int i = 0; i < 31; ++i) p.in[i] = (const float*)d_in[i];
    p.out = (float*)d_out; p.ws = (unsigned char*)d_ws;
#if COOP
    hipMemsetAsync((unsigned char*)d_ws + O_BAR, 0, XCD_BAR_WORDS * 4, stream);
    int lo = 0, hi = NPH;
    void* args[] = {&p, &lo, &hi};
    hipError_t e = hipLaunchCooperativeKernel((const void*)mega, dim3(grid_blocks), dim3(512), args, LDS_BYTES, stream);
    if (e != hipSuccess) fprintf(stderr, "cooperative launch failed: %s (grid %d)\n", hipGetErrorString(e), grid_blocks);
#else
#ifdef DBG_STOP
    for (int ph = 0; ph <= DBG_STOP; ++ph) mega<<<grid_blocks, 512, LDS_BYTES, stream>>>(p, ph, ph + 1);
    dbg_copy<<<2048, 256, 0, stream>>>((const float*)((unsigned char*)d_ws + DBG_OFF), (size_t)DBG_N, (float*)d_out, (size_t)out_size);
    unsigned* cnt = (unsigned*)((unsigned char*)d_ws + O_MOD + 250000);
    hipMemsetAsync(cnt, 0, 8, stream);
    dbg_stat<<<2048, 256, 0, stream>>>((const unsigned short*)((unsigned char*)d_ws + DBG_SOFF), (size_t)DBG_SN, (float*)d_out, cnt);
    dbg_fin<<<1, 1, 0, stream>>>((float*)d_out, cnt, (double)DBG_SN);
#else
    for (int ph = 0; ph < NPH; ++ph) mega<<<grid_blocks, 512, LDS_BYTES, stream>>>(p, ph, ph + 1);
#endif
#endif
}
```
